# Optimizing an MI355X kernel written in HIP

```python
import math
import jax, jax.numpy as jnp
from jax import lax
import numpy as np

D_MODEL = 1024
BATCH = 16
SEQ = 2048
DEPTH = 2
DEC_BATCH = 8
DEC_SEQ = 8192
PAST_LEN = 128

HEAD_DIM = 64
DIL_GROUPS = ((128, 1), (512, 4), (2048, 16))
HEADS_PER_GROUP = 4
N_HEADS_A = HEADS_PER_GROUP * len(DIL_GROUPS)
N_HEADS_B = 8
N_HEADS = N_HEADS_A + N_HEADS_B
WIDTH_A = HEADS_PER_GROUP * HEAD_DIM
WIDTH_B = N_HEADS_B * HEAD_DIM
QKV_WIDTH = 3 * N_HEADS * HEAD_DIM
BLK_A = 64
N_BUCKETS = 32
MAX_DISTANCE = 1024
GRID_W = 64
KH_MAX = 8
KW = 16
QRB = 2
QCB = 16
KCB = 32
D_FF = 4 * D_MODEL
N_MOD = 6
EPS = 1e-6
NEG = -1e30

kernel_name = 'dilated_natten_gated_hybrid_encoder'


def rms_norm(x, g):
    xf = x.astype(jnp.float32)
    y = xf * lax.rsqrt(jnp.mean(xf * xf, axis=-1, keepdims=True) + EPS)
    return (y * g.astype(jnp.float32)).astype(x.dtype)


def t5_bucket(rel):
    nb = N_BUCKETS // 2
    max_exact = nb // 2
    ret = (rel > 0).astype(np.int32) * nb
    n = np.abs(rel)
    large = max_exact + (np.log(np.maximum(n, 1) / max_exact) / np.log(MAX_DISTANCE / max_exact) * (nb - max_exact)).astype(np.int32)
    large = np.minimum(large, nb - 1)
    return (ret + np.where(n < max_exact, n, large)).astype(np.int32)


def dilated_group(q, k, v, table, d, half):
    B_, L, H, E = q.shape
    n = L // d
    nb = -(-n // BLK_A)
    n_pad = nb * BLK_A

    def sub(t):
        return t.reshape(B_, n, d, H, E).transpose(0, 2, 1, 3, 4)

    qs = jnp.pad(sub(q), ((0, 0), (0, 0), (0, n_pad - n), (0, 0), (0, 0))).reshape(B_, d, nb, BLK_A, H, E)

    def windows(t):
        tp = jnp.pad(sub(t), ((0, 0), (0, 0), (BLK_A, n_pad - n + BLK_A), (0, 0), (0, 0)))
        tp = tp.reshape(B_, d, nb + 2, BLK_A, H, E)
        return jnp.concatenate([tp[:, :, :-2], tp[:, :, 1:-1], tp[:, :, 2:]], axis=3)

    kw, vw = windows(k), windows(v)
    j = np.arange(3 * BLK_A)[None, :] - BLK_A - np.arange(BLK_A)[:, None]
    bias = jnp.transpose(table[t5_bucket(d * j)], (2, 0, 1)).astype(jnp.float32)
    key_idx = np.arange(nb)[:, None] * BLK_A + np.arange(3 * BLK_A)[None, :] - BLK_A
    mask = (np.abs(j) <= half)[None] & ((key_idx >= 0) & (key_idx < n))[:, None, :]
    s = jnp.einsum('bdiqhe,bdikhe->bdihqk', qs, kw, preferred_element_type=jnp.float32) * (HEAD_DIM ** -0.5) + bias
    s = jnp.where(mask[:, None], s, NEG)
    lse = jax.nn.logsumexp(s, axis=-1)
    p = jnp.exp(s - lse[..., None]).astype(v.dtype)
    o = jnp.einsum('bdihqk,bdikhe->bdiqhe', p, vw).reshape(B_, d, n_pad, H, E)[:, :, :n]
    o = o.transpose(0, 2, 1, 3, 4).reshape(B_, L, H, E)
    lse = lse.transpose(0, 1, 2, 4, 3).reshape(B_, d, n_pad, H)[:, :, :n]
    lse = lse.transpose(0, 2, 1, 3).reshape(B_, L, H)
    return o, lse


def dilated_mixer(q, k, v, table):
    B_, L, _, E = q.shape
    outs, lses = [], []
    for g, (w, d) in enumerate(DIL_GROUPS):
        sl = slice(g * HEADS_PER_GROUP, (g + 1) * HEADS_PER_GROUP)
        o, l = dilated_group(q[:, :, sl], k[:, :, sl], v[:, :, sl], table[:, sl], d, w // (2 * d))
        outs.append(o)
        lses.append(l)
    wts = jax.nn.softmax(jnp.stack(lses, axis=0), axis=0)
    o = jnp.sum(wts[..., None].astype(q.dtype) * jnp.stack(outs, axis=0), axis=0)
    return o.reshape(B_, L, WIDTH_A)


def neighborhood_mixer(q, k, v, rpb):
    B_, L, H, E = q.shape
    rows = L // GRID_W
    kh = min(KH_MAX, rows)
    krb = min(kh + 2, rows)
    n_rb = rows // QRB
    n_cb = GRID_W // QCB
    q_rows = np.arange(n_rb)[:, None] * QRB + np.arange(QRB)[None, :]
    r_start = np.clip(q_rows - kh // 2, 0, rows - kh)
    band = np.clip(np.arange(n_rb) * QRB - kh // 2, 0, rows - krb)
    k_rows = band[:, None] + np.arange(krb)[None, :]
    row_ok = (k_rows[:, None, :] >= r_start[:, :, None]) & (k_rows[:, None, :] < r_start[:, :, None] + kh)
    dr = np.clip(k_rows[:, None, :] - q_rows[:, :, None], 1 - KH_MAX, KH_MAX - 1) + KH_MAX - 1
    q_cols = np.arange(n_cb)[:, None] * QCB + np.arange(QCB)[None, :]
    c_start = np.clip(q_cols - KW // 2, 0, GRID_W - KW)
    k_cols = np.clip(np.arange(n_cb) * QCB - KW // 2, 0, GRID_W - KCB)[:, None] + np.arange(KCB)[None, :]
    col_ok = (k_cols[:, None, :] >= c_start[:, :, None]) & (k_cols[:, None, :] < c_start[:, :, None] + KW)
    dc = np.clip(k_cols[:, None, :] - q_cols[:, :, None], 1 - KW, KW - 1) + KW - 1
    qg = q.reshape(B_, rows, GRID_W, H, E)
    kg = k.reshape(B_, rows, GRID_W, H, E)
    vg = v.reshape(B_, rows, GRID_W, H, E)
    scale = HEAD_DIM ** -0.5

    def block(args):
        a, b0, rok, dri = args
        qb = lax.dynamic_slice_in_dim(qg, a * QRB, QRB, axis=1).reshape(B_, QRB, n_cb, QCB, H, E)
        kb = lax.dynamic_slice_in_dim(kg, b0, krb, axis=1)[:, :, k_cols]
        vb = lax.dynamic_slice_in_dim(vg, b0, krb, axis=1)[:, :, k_cols]
        s = jnp.einsum('bqnchd,bknjhd->bnhqckj', qb, kb, preferred_element_type=jnp.float32) * scale
        bias = rpb[:, dri[None, :, None, :, None], dc[:, None, :, None, :]]
        ok = rok[None, :, None, :, None] & col_ok[:, None, :, None, :]
        s = jnp.where(ok[:, None], s + jnp.moveaxis(bias, 0, 1).astype(jnp.float32), NEG)
        p = jax.nn.softmax(s.reshape(s.shape[:-2] + (krb * KCB,)), axis=-1).reshape(s.shape).astype(v.dtype)
        o = jnp.einsum('bnhqckj,bknjhd->bqnchd', p, vb)
        return o.reshape(B_, QRB, GRID_W, H, E)

    xs = (jnp.arange(n_rb, dtype=jnp.int32), jnp.asarray(band, dtype=jnp.int32), jnp.asarray(row_ok), jnp.asarray(dr, dtype=jnp.int32))
    out = lax.map(block, xs)
    return out.transpose(1, 0, 2, 3, 4, 5).reshape(B_, L, H * E)


def layer(x, c, norm1_g, norm2_g, w_mod, b_mod, w_in, q_norm_g, k_norm_g, rel_bias, rpb, w_gate, b_gate, w_up_a, w_up_b, w_o, w_ff1, w_ff2):
    B_, L, _ = x.shape
    mod = (jax.nn.silu(c) @ w_mod + b_mod)[:, None, :]
    sh1, sc1, g1, sh2, sc2, g2 = jnp.split(mod, N_MOD, axis=-1)
    h = rms_norm(x, norm1_g) * (1 + sc1) + sh1
    qkv = (h @ w_in).reshape(B_, L, 3, N_HEADS, HEAD_DIM)
    q = rms_norm(qkv[:, :, 0], q_norm_g)
    k = rms_norm(qkv[:, :, 1], k_norm_g)
    v = qkv[:, :, 2]
    o_a = dilated_mixer(q[:, :, :N_HEADS_A], k[:, :, :N_HEADS_A], v[:, :, :N_HEADS_A], rel_bias)
    o_b = neighborhood_mixer(q[:, :, N_HEADS_A:], k[:, :, N_HEADS_A:], v[:, :, N_HEADS_A:], rpb)
    gate_a, gate_b = jnp.split(jax.nn.sigmoid(h @ w_gate + b_gate), 2, axis=-1)
    mixed = gate_a * (o_a @ w_up_a) + gate_b * (o_b @ w_up_b)
    x = x + g1 * (mixed @ w_o)
    h2 = rms_norm(x, norm2_g) * (1 + sc2) + sh2
    f = jnp.square(jax.nn.relu(h2 @ w_ff1)) @ w_ff2
    return x + g2 * f


def setup_inputs(seed: int = 0) -> dict:
    key = jax.random.key(seed)
    ks = jax.random.split(key, 20)

    def nrm(k, shape, s):
        return jax.random.normal(k, shape, jnp.float32) * s

    return {
        'x_prompt': nrm(ks[0], (BATCH, SEQ, D_MODEL), 1.0),
        'x_sample': nrm(ks[1], (DEC_BATCH, DEC_SEQ, D_MODEL), 1.0),
        'c_prompt': nrm(ks[2], (BATCH, D_MODEL), 1.0),
        'c_sample': nrm(ks[3], (DEC_BATCH, D_MODEL), 1.0),
        'norm1_g': 1.0 + nrm(ks[4], (DEPTH, D_MODEL), 0.05),
        'norm2_g': 1.0 + nrm(ks[5], (DEPTH, D_MODEL), 0.05),
        'w_mod': nrm(ks[6], (DEPTH, D_MODEL, N_MOD * D_MODEL), 0.5 * D_MODEL ** -0.5),
        'b_mod': nrm(ks[7], (DEPTH, N_MOD * D_MODEL), 0.02),
        'w_in': nrm(ks[8], (DEPTH, D_MODEL, QKV_WIDTH), D_MODEL ** -0.5),
        'q_norm_g': 1.0 + nrm(ks[9], (DEPTH, N_HEADS, HEAD_DIM), 0.05),
        'k_norm_g': 1.0 + nrm(ks[10], (DEPTH, N_HEADS, HEAD_DIM), 0.05),
        'rel_bias': nrm(ks[11], (N_BUCKETS, N_HEADS_A), 0.5),
        'rpb': nrm(ks[12], (DEPTH, N_HEADS_B, 2 * KH_MAX - 1, 2 * KW - 1), 0.5),
        'w_gate': nrm(ks[13], (DEPTH, D_MODEL, 2 * D_MODEL), D_MODEL ** -0.5),
        'b_gate': nrm(ks[14], (DEPTH, 2 * D_MODEL), 0.02),
        'w_up_a': nrm(ks[15], (DEPTH, WIDTH_A, D_MODEL), WIDTH_A ** -0.5),
        'w_up_b': nrm(ks[16], (DEPTH, WIDTH_B, D_MODEL), WIDTH_B ** -0.5),
        'w_o': nrm(ks[17], (DEPTH, D_MODEL, D_MODEL), D_MODEL ** -0.5),
        'w_ff1': nrm(ks[18], (DEPTH, D_MODEL, D_FF), D_MODEL ** -0.5),
        'w_ff2': nrm(ks[19], (DEPTH, D_FF, D_MODEL), D_FF ** -0.5),
    }


def reference(x_prompt, x_sample, c_prompt, c_sample, norm1_g, norm2_g, w_mod, b_mod, w_in, q_norm_g, k_norm_g, rel_bias, rpb, w_gate, b_gate, w_up_a, w_up_b, w_o, w_ff1, w_ff2):
    y_prompt = x_prompt
    y_sample = x_sample
    for l in range(DEPTH):
        y_prompt = layer(y_prompt, c_prompt, norm1_g[l], norm2_g[l], w_mod[l], b_mod[l], w_in[l], q_norm_g[l], k_norm_g[l], rel_bias, rpb[l], w_gate[l], b_gate[l], w_up_a[l], w_up_b[l], w_o[l], w_ff1[l], w_ff2[l])
        y_sample = layer(y_sample, c_sample, norm1_g[l], norm2_g[l], w_mod[l], b_mod[l], w_in[l], q_norm_g[l], k_norm_g[l], rel_bias, rpb[l], w_gate[l], b_gate[l], w_up_a[l], w_up_b[l], w_o[l], w_ff1[l], w_ff2[l])
    return (y_prompt, y_sample)
```

```cpp
#include <hip/hip_runtime.h>
#include <hip/hip_cooperative_groups.h>
#include <cstdio>
#include <cstdint>
namespace cg = cooperative_groups;
namespace pg8 {
#define PG8_LAS __attribute__((address_space(3)))
typedef unsigned short bf16_t;
typedef short bf16x8 __attribute__((ext_vector_type(8)));
typedef float f32x4 __attribute__((ext_vector_type(4)));
typedef unsigned u32x4 __attribute__((ext_vector_type(4)));
constexpr int BM = 256, BK = 64, HALF = 128, HTB = HALF * BK * 2  , STAGE_BYTES = 8 * HTB, NXCD = 8, WGM = 8;

__host__ __device__ __forceinline__ int lds_byte(int r, int c) { const int st = (r >> 4) * 2 + (c >> 5), rr = r & 15, cc = c & 31, ob = rr * 64 + cc * 2; return st * 1024 + (ob ^ (((ob >> 9) & 1) << 5)); }
__host__ __device__ __forceinline__ void stage_rc(int b, int& R, int& C) { const int st = b / 1024, sb = b % 1024, swz = sb ^ (((sb >> 9) & 1) << 5); R = (st >> 1) * 16 + swz / 64; C = (st & 1) * 32 + (swz % 64) / 2; }
__host__ __device__ __forceinline__ int perm32(int rho) { const int n = rho >> 4, i = rho & 15; return 8 * (i >> 2) + 4 * n + (i & 3); }

struct Unit { int pm, pn; };
struct Gemm { const bf16_t* A; const bf16_t* Bt; int M, N, K; };

struct StaticOrder {
    int nM, nN, nwg, G, c;
    __host__ __device__ void init(int M, int N, int G_, int c_) { nM = M / BM; nN = N / BM; nwg = nM * nN; G = G_; c = c_; }
    __host__ __device__ bool next(int i, Unit& u) const {
        const long L = (long)i * G + c; if (L >= nwg) return false;
        int wgid = (int)L; { const int q = nwg / NXCD, r = nwg % NXCD, xcd = wgid % NXCD, off = wgid / NXCD; wgid = (xcd < r ? xcd * (q + 1) : r * (q + 1) + (xcd - r) * q) + off; }
        const int nig = WGM * nN, gid = wgid / nig, fm = gid * WGM, gsz = (nM - fm) < WGM ? (nM - fm) : WGM;
        u.pm = fm + ((wgid % nig) % gsz); u.pn = (wgid % nig) / gsz; return true;
    }
    __device__ __forceinline__ void a_ready(const Unit&) const {}
    __device__ __forceinline__ void done(const Unit&) const {}
};

__device__ __forceinline__ unsigned cvt_pk_bf16(float lo, float hi) { unsigned r; asm volatile("v_cvt_pk_bf16_f32 %0, %1, %2" : "=v"(r) : "v"(lo), "v"(hi)); return r; }
template <class Epi, class Sched, bool ALIGN_EPI = false, bool SP2 = false>
__device__ __forceinline__ void gemm_phase(PG8_LAS unsigned char* lds, const Gemm g, const Sched& S, const Epi& E) {
    int tid_o = threadIdx.x; asm volatile("" : "+v"(tid_o));
    const int tid = tid_o, wid = __builtin_amdgcn_readfirstlane(tid >> 6), lane = tid & 63, wr = wid >> 2, wc = wid & 3, fr = lane & 15, fq = lane >> 4;
    const int K = g.K, nt = K / BK;
    unsigned voffA[2], voffB[2];
#pragma unroll
    for (int i = 0; i < 2; ++i) { int R, C; stage_rc(tid * 16 + i * 8192, R, C); const int Rb = Epi::PERM ? ((R & ~31) + perm32(R & 31)) : R;
        voffA[i] = (unsigned)(R * K + C) * 2u; voffB[i] = (unsigned)(Rb * K + C) * 2u; }
    const size_t kstep = (size_t)(BK * 2);
    const size_t hstep = (size_t)HALF * K * 2;
    const size_t tstep = 2 * hstep;
    const unsigned ldsw = (unsigned)wid * 1024u;
    const int aoff = lds_byte(wr * 64 + fr, fq * 8), boff = lds_byte(wc * 32 + fr, fq * 8);
#define PG8_SA(b, h) (((b) * 2 + (h)) * HTB)
#define PG8_SB(b, h) ((4 + (b) * 2 + (h)) * HTB)
#define PG8_STAGE(bufoff, gbase, voff) do { _Pragma("unroll") for (int _i = 0; _i < 2; ++_i) \
        __builtin_amdgcn_global_load_lds((const unsigned*)((const char*)(gbase) + (voff)[_i]), (PG8_LAS unsigned*)(lds + (bufoff) + ldsw + _i * 8192), 16, 0, 0); } while (0)
#define PG8_LDA(dst, b, h) do { _Pragma("unroll") for (int m = 0; m < 4; ++m) _Pragma("unroll") for (int k = 0; k < 2; ++k) dst[m][k] = *(const PG8_LAS bf16x8*)(lds + PG8_SA(b, h) + aoff + m * 2048 + k * 1024); } while (0)
#define PG8_LDB(dst, b, h) do { _Pragma("unroll") for (int n = 0; n < 2; ++n) _Pragma("unroll") for (int k = 0; k < 2; ++k) dst[n][k] = *(const PG8_LAS bf16x8*)(lds + PG8_SB(b, h) + boff + n * 2048 + k * 1024); } while (0)
#define PG8_MMA(ai, bj, At, Bt) do { __builtin_amdgcn_s_setprio(1); _Pragma("unroll") for (int m = 0; m < 4; ++m) _Pragma("unroll") for (int n = 0; n < 2; ++n) _Pragma("unroll") for (int k = 0; k < 2; ++k) \
        acc[ai][bj][m][n] = __builtin_amdgcn_mfma_f32_16x16x32_bf16(Bt[n][k], At[m][k], acc[ai][bj][m][n], 0, 0, 0); __builtin_amdgcn_s_setprio(0); } while (0)
#define PG8_WAIT_V(n) asm volatile("s_waitcnt vmcnt(" #n ")" ::: "memory")
#define PG8_WAIT_L(n) asm volatile("s_waitcnt lgkmcnt(" #n ")" ::: "memory")
#define PG8_BAR __builtin_amdgcn_s_barrier()
#define PG8_SCHED __builtin_amdgcn_sched_barrier(0)
    Unit cur, nxt; int ui = 0;
    if (!S.next(0, cur)) return;
    f32x4 acc[2][2][4][2];
#pragma unroll
    for (int a = 0; a < 2; ++a)
#pragma unroll
        for (int b = 0; b < 2; ++b)
#pragma unroll
            for (int m = 0; m < 4; ++m)
#pragma unroll
                for (int n = 0; n < 2; ++n) acc[a][b][m][n] = (f32x4){0.f, 0.f, 0.f, 0.f};
    bf16x8 At[4][2], B0[2][2], B1[2][2];
    const char* cA = (const char*)g.A + (size_t)cur.pm * tstep; const char* cB = (const char*)g.Bt + (size_t)cur.pn * tstep;
    S.a_ready(cur);
    if constexpr (SP2) {
        PG8_STAGE(PG8_SB(0, 0), cB, voffB); PG8_STAGE(PG8_SB(0, 1), cB + hstep, voffB); PG8_STAGE(PG8_SA(0, 0), cA, voffA); PG8_STAGE(PG8_SA(0, 1), cA + hstep, voffA);
        if (wr == 1) PG8_BAR;
        PG8_WAIT_V(2); PG8_BAR;
        PG8_STAGE(PG8_SB(1, 0), cB + kstep, voffB); PG8_STAGE(PG8_SA(1, 0), cA + kstep, voffA); PG8_STAGE(PG8_SB(1, 1), cB + hstep + kstep, voffB);
        PG8_WAIT_V(6); PG8_BAR;
    } else {
        PG8_STAGE(PG8_SB(0, 0), cB, voffB); PG8_STAGE(PG8_SA(0, 0), cA, voffA); PG8_STAGE(PG8_SB(0, 1), cB + hstep, voffB); PG8_STAGE(PG8_SA(0, 1), cA + hstep, voffA);
        if (wr == 1) PG8_BAR;
        PG8_WAIT_V(4); PG8_BAR;
        PG8_STAGE(PG8_SB(1, 0), cB + kstep, voffB); PG8_STAGE(PG8_SA(1, 0), cA + kstep, voffA); PG8_STAGE(PG8_SB(1, 1), cB + hstep + kstep, voffB);
        PG8_WAIT_V(6); PG8_BAR;
    }
    for (;;) {
        const bool has_next = S.next(ui + 1, nxt);
        const char* nA = has_next ? (const char*)g.A + (size_t)nxt.pm * tstep : cA; const char* nB = has_next ? (const char*)g.Bt + (size_t)nxt.pn * tstep : cB;
        for (int t = 0; t < nt; t += 2) {
            if constexpr (Epi::MIDK > 0) { if (t == Epi::MIDK) { __builtin_amdgcn_sched_barrier(0); E.mid(acc, cur, wr, wc, fr, fq); __builtin_amdgcn_sched_barrier(0); } }
            const bool last = (t == nt - 2);
            const char* a1 = cA + (size_t)(t + 1) * kstep;
            const char* a2 = last ? nA : cA + (size_t)(t + 2) * kstep; const char* b2 = last ? nB : cB + (size_t)(t + 2) * kstep;
            const char* a3 = a2 + kstep; const char* b3 = b2 + kstep;
            if (last && has_next) S.a_ready(nxt);
            if constexpr (SP2) {
            PG8_LDB(B0, 0, 0); PG8_LDB(B1, 0, 1); PG8_SCHED; PG8_LDA(At, 0, 0); PG8_STAGE(PG8_SA(1, 1), a1 + hstep, voffA);
            PG8_WAIT_V(8); PG8_WAIT_L(0); PG8_BAR; PG8_MMA(0, 0, At, B0); PG8_MMA(0, 1, At, B1); PG8_BAR; PG8_SCHED;
            PG8_LDA(At, 0, 1); PG8_STAGE(PG8_SB(0, 0), b2, voffB); PG8_STAGE(PG8_SB(0, 1), b2 + hstep, voffB); PG8_STAGE(PG8_SA(0, 0), a2, voffA);
            PG8_WAIT_V(8); PG8_WAIT_L(0); PG8_BAR; PG8_MMA(1, 0, At, B0); PG8_MMA(1, 1, At, B1); PG8_BAR; PG8_SCHED;
            PG8_LDB(B0, 1, 0); PG8_LDB(B1, 1, 1); PG8_SCHED; PG8_LDA(At, 1, 0); PG8_STAGE(PG8_SA(0, 1), a2 + hstep, voffA);
            PG8_WAIT_V(8); PG8_WAIT_L(0); PG8_BAR; PG8_MMA(0, 0, At, B0); PG8_MMA(0, 1, At, B1); PG8_BAR; PG8_SCHED;
            PG8_LDA(At, 1, 1); PG8_STAGE(PG8_SB(1, 0), b3, voffB); PG8_STAGE(PG8_SB(1, 1), b3 + hstep, voffB); PG8_STAGE(PG8_SA(1, 0), a3, voffA);
            PG8_WAIT_V(8); PG8_WAIT_L(0); PG8_BAR; PG8_MMA(1, 0, At, B0); PG8_MMA(1, 1, At, B1); PG8_BAR; PG8_SCHED;
            } else {
            PG8_LDB(B0, 0, 0); PG8_SCHED; PG8_LDA(At, 0, 0); PG8_STAGE(PG8_SA(1, 1), a1 + hstep, voffA);
            PG8_WAIT_L(8); PG8_BAR; PG8_WAIT_L(0); PG8_MMA(0, 0, At, B0); PG8_BAR; PG8_SCHED;
            PG8_LDB(B1, 0, 1); PG8_STAGE(PG8_SB(0, 0), b2, voffB);
            PG8_BAR; PG8_WAIT_L(0); PG8_MMA(0, 1, At, B1); PG8_BAR;
            PG8_LDA(At, 0, 1); PG8_STAGE(PG8_SA(0, 0), a2, voffA);
            PG8_BAR; PG8_WAIT_L(0); PG8_MMA(1, 0, At, B0); PG8_BAR; PG8_SCHED;
            PG8_STAGE(PG8_SB(0, 1), b2 + hstep, voffB);
            PG8_WAIT_V(6); PG8_BAR; PG8_MMA(1, 1, At, B1); PG8_BAR;
            PG8_LDB(B0, 1, 0); PG8_SCHED; PG8_LDA(At, 1, 0); PG8_STAGE(PG8_SA(0, 1), a2 + hstep, voffA);
            PG8_WAIT_L(8); PG8_BAR; PG8_WAIT_L(0); PG8_MMA(0, 0, At, B0); PG8_BAR; PG8_SCHED;
            PG8_LDB(B1, 1, 1); PG8_STAGE(PG8_SB(1, 0), b3, voffB);
            PG8_BAR; PG8_WAIT_L(0); PG8_MMA(0, 1, At, B1); PG8_BAR;
            PG8_LDA(At, 1, 1); PG8_STAGE(PG8_SA(1, 0), a3, voffA);
            PG8_BAR; PG8_WAIT_L(0); PG8_MMA(1, 0, At, B0); PG8_BAR; PG8_SCHED;
            PG8_STAGE(PG8_SB(1, 1), b3 + hstep, voffB);
            PG8_WAIT_V(6); PG8_BAR; PG8_MMA(1, 1, At, B1); PG8_BAR;
            }
        }
        if constexpr (ALIGN_EPI) { if (wr == 0) PG8_BAR; }
        if constexpr (!Epi::AFTER_DRAIN) { E(acc, cur, wr, wc, fr, fq); S.done(cur); }
        if (!has_next) break;
#pragma unroll
        for (int a = 0; a < 2; ++a)
#pragma unroll
            for (int b = 0; b < 2; ++b)
#pragma unroll
                for (int m = 0; m < 4; ++m)
#pragma unroll
                    for (int n = 0; n < 2; ++n) acc[a][b][m][n] = (f32x4){0.f, 0.f, 0.f, 0.f};
        cur = nxt; cA = nA; cB = nB; ++ui;
        if constexpr (ALIGN_EPI) { if (wr == 1) PG8_BAR; }
    }
    PG8_WAIT_V(0);
    if constexpr (!ALIGN_EPI) { if (wr == 0) PG8_BAR; }
    PG8_BAR;
    if constexpr (Epi::AFTER_DRAIN) { E.fused(acc, cur, wr, wc, fr, fq, lds, wid, lane); S.done(cur); }
#undef PG8_SA
#undef PG8_SB
#undef PG8_STAGE
#undef PG8_LDA
#undef PG8_LDB
#undef PG8_MMA
#undef PG8_WAIT_V
#undef PG8_WAIT_L
#undef PG8_BAR
#undef PG8_SCHED
}
}

#define LAS __attribute__((address_space(3)))
typedef unsigned short bf16_t;
typedef short bf16x8 __attribute__((ext_vector_type(8)));
typedef short s16x4 __attribute__((ext_vector_type(4)));
typedef float f32x4 __attribute__((ext_vector_type(4)));
typedef float f32x16 __attribute__((ext_vector_type(16)));
typedef unsigned u32x4 __attribute__((ext_vector_type(4)));
typedef unsigned u32x2 __attribute__((ext_vector_type(2)));

constexpr int DM = 1024, MP = 32768, M_ALL = 98304, NQKV = 3840, NG1 = 5888, DFF = 4096, NMOD = 6144;
constexpr int NQ = 1280, KVROW = 128;
constexpr int NCHUNK = 3, MC = 32768;
constexpr float EPS = 1e-6f, LOG2E = 1.4426950408889634f, QSCALE = 0.125f * LOG2E, NEGB = -1e30f;
constexpr int NWAVES = 8, NTHREADS = 512;
constexpr int LDS_MISC = 155648, LDS_BYTES = 156672;

constexpr size_t W_BT1 = 0, W_UA = 6029312, W_UB = 6291456, W_O = 6815744, W_F1 = 7864320, W_F2 = 12058624, W_LAYER = 16252928;
constexpr size_t MiB = 1u << 20;
constexpr size_t WS_MOD = 0;
constexpr size_t WS_CTL = 1536 * 1024, CTL_BYTES = 16384;
constexpr size_t WS_W = 2 * MiB;
constexpr size_t WS_H = 66 * MiB;
constexpr size_t WS_QKV = 130 * MiB;
constexpr size_t WS_G = 370 * MiB;
constexpr size_t WS_OA = 498 * MiB;
constexpr size_t WS_OB = 514 * MiB;
constexpr size_t WS_OACC = 546 * MiB;
constexpr size_t WS_LACC = 578 * MiB;
constexpr size_t WS_XS = 579 * MiB;
constexpr size_t WS_SSQ = 643 * MiB;
constexpr size_t WS_BF1 = 645 * MiB;
constexpr size_t WS_BG1 = 646 * MiB;
constexpr size_t WS_END = 647 * MiB;

typedef float f32x2_t __attribute__((ext_vector_type(2))); typedef __bf16 bf16x2_t __attribute__((ext_vector_type(2)));
__device__ __forceinline__ unsigned cvtpk(float lo, float hi) { f32x2_t v = {lo, hi}; bf16x2_t b = __builtin_convertvector(v, bf16x2_t); return __builtin_bit_cast(unsigned, b); }
__device__ __forceinline__ float bf_lo(unsigned w) { return __uint_as_float(w << 16); }
__device__ __forceinline__ float bf_hi(unsigned w) { return __uint_as_float(w & 0xffff0000u); }
__device__ __forceinline__ void st8_wt(__amdgpu_buffer_rsrc_t rs, unsigned off, u32x2 v) { __builtin_amdgcn_raw_buffer_store_b64(v, rs, off, 0, 16); }
__device__ __forceinline__ int batch_of(int grow) { return grow < MP ? (grow >> 11) : 16 + ((grow - MP) >> 13); }

__device__ __forceinline__ int kv_srow(int row, int sst, int dsh, int lsh) { const int t = row - sst; return sst + ((t & ((1 << dsh) - 1)) << (lsh - dsh)) + (t >> dsh); }
__device__ __forceinline__ float row_rstd(const float* ssqp, int row) {
    const f32x4* sp = (const f32x4*)(ssqp + (size_t)row * 16);
    const f32x4 s4 = (sp[0] + sp[1]) + (sp[2] + sp[3]);
    return __builtin_amdgcn_rsqf(((s4[0] + s4[1]) + (s4[2] + s4[3])) * (1.0f / DM) + EPS);
}
struct EpiQKVG {
    static constexpr bool PERM = true, AFTER_DRAIN = false; static constexpr int MIDK = 0;
    bf16_t* QKV; bf16_t* G; const float* qg; const float* kg; const float* bgate; int m0;
    __device__ __forceinline__ void operator()(const pg8::f32x4 (&acc)[2][2][4][2], const pg8::Unit& u, int wr, int wc, int fr, int fq) const {
        const int row0 = u.pm * 256 + wr * 64 + fr, pn = u.pn;
        const int lc0 = pn * 256 + wc * 64 + fq * 8;
        const int grow0 = m0 + u.pm * 256;
        const int sst = (grow0 < MP ? (grow0 & ~2047) : MP + ((grow0 - MP) & ~8191)) - m0, lsh = grow0 < MP ? 11 : 13;
        const int hgrp = pn < 10 ? pn - 5 : pn - 10, dsh = hgrp == 1 ? 2 : (hgrp == 2 ? 4 : 0);
#define QKVG_VAL(ai, m, bj, n, rs_) (acc[ai][bj][m][n])
#define QKVG_RS(row_) (1.0f)
#ifdef DIAG_PLAIN_G1
        if (false) {
#else
        if (pn < 10) {
#endif
            const bool isq = pn < 5;
            const int head = (isq ? pn : pn - 5) * 4 + wc;
            const float* gp = (isq ? qg : kg) + head * 64 + fq * 8;
            const float sc = isq ? QSCALE : 1.0f;
            f32x4 gv[2][2];
#pragma unroll
            for (int bj = 0; bj < 2; ++bj)
#pragma unroll
                for (int n = 0; n < 2; ++n) gv[bj][n] = *(const f32x4*)(gp + bj * 32 + n * 4) * sc;
#pragma unroll
            for (int ai = 0; ai < 2; ++ai)
#pragma unroll
                for (int m = 0; m < 4; ++m) {
                    const float rr = QKVG_RS(row0 + ai * 128 + m * 16);
                    f32x4 xv[2][2]; float ss = 0.f;
#pragma unroll
                    for (int bj = 0; bj < 2; ++bj)
#pragma unroll
                        for (int n = 0; n < 2; ++n) { const f32x4 x = QKVG_VAL(ai, m, bj, n, rr); xv[bj][n] = x; ss += (x[0] * x[0] + x[1] * x[1]) + (x[2] * x[2] + x[3] * x[3]); }
                    ss += __shfl_xor(ss, 16); ss += __shfl_xor(ss, 32);
                    const float rs = __builtin_amdgcn_rsqf(ss * (1.0f / 64.0f) + EPS);
                    bf16_t* rowp = isq ? QKV + (size_t)(row0 + ai * 128 + m * 16) * NQ + lc0
                                       : QKV + (size_t)MC * NQ + ((size_t)head * MC + kv_srow(row0 + ai * 128 + m * 16, sst, dsh, lsh)) * KVROW + fq * 8;
#pragma unroll
                    for (int bj = 0; bj < 2; ++bj) {
                        const f32x4 v0 = xv[bj][0] * rs * gv[bj][0], v1 = xv[bj][1] * rs * gv[bj][1];
                        u32x4 w; w.x = cvtpk(v0[0], v0[1]); w.y = cvtpk(v0[2], v0[3]); w.z = cvtpk(v1[0], v1[1]); w.w = cvtpk(v1[2], v1[3]);
                        *(u32x4*)(rowp + bj * 32) = w;
                    }
                    asm volatile("" ::: "memory");
                }
        } else if (pn < 15) {
#pragma unroll
            for (int ai = 0; ai < 2; ++ai)
#pragma unroll
                for (int m = 0; m < 4; ++m) {
                    bf16_t* rowp = QKV + (size_t)MC * NQ + ((size_t)((pn - 10) * 4 + wc) * MC + kv_srow(row0 + ai * 128 + m * 16, sst, dsh, lsh)) * KVROW + 64 + fq * 8;
                    const float rr = QKVG_RS(row0 + ai * 128 + m * 16);
#pragma unroll
                    for (int bj = 0; bj < 2; ++bj) {
                        const f32x4 v0 = QKVG_VAL(ai, m, bj, 0, rr), v1 = QKVG_VAL(ai, m, bj, 1, rr);
                        u32x4 w; w.x = cvtpk(v0[0], v0[1]); w.y = cvtpk(v0[2], v0[3]); w.z = cvtpk(v1[0], v1[1]); w.w = cvtpk(v1[2], v1[3]);
                        *(u32x4*)(rowp + bj * 32) = w;
                    }
                }
        } else {
            const int oc = (pn - 15) * 128 + wc * 32 + fq * 8;
            f32x4 ba[2], bb[2];
#pragma unroll
            for (int n = 0; n < 2; ++n) { ba[n] = *(const f32x4*)(bgate + oc + n * 4); bb[n] = *(const f32x4*)(bgate + 1024 + oc + n * 4); }
#pragma unroll
            for (int ai = 0; ai < 2; ++ai)
#pragma unroll
                for (int m = 0; m < 4; ++m) {
                    bf16_t* rowp = G + (size_t)(row0 + ai * 128 + m * 16) * 2048 + oc;
                    f32x4 ga[2], gr[2];
#pragma unroll
                    for (int n = 0; n < 2; ++n) {
                        const f32x4 xa = acc[ai][0][m][n] + ba[n], xb = acc[ai][1][m][n] + bb[n];
#pragma unroll
                        for (int e = 0; e < 4; ++e) { const float ea = 1.0f + __builtin_amdgcn_exp2f(-LOG2E * xa[e]), eb = 1.0f + __builtin_amdgcn_exp2f(-LOG2E * xb[e]);
                            ga[n][e] = __builtin_amdgcn_rcpf(ea); gr[n][e] = ea * __builtin_amdgcn_rcpf(eb); }
                    }
                    u32x4 w; w.x = cvtpk(ga[0][0], ga[0][1]); w.y = cvtpk(ga[0][2], ga[0][3]); w.z = cvtpk(ga[1][0], ga[1][1]); w.w = cvtpk(ga[1][2], ga[1][3]);
                    *(u32x4*)rowp = w;
                    u32x4 w2; w2.x = cvtpk(gr[0][0], gr[0][1]); w2.y = cvtpk(gr[0][2], gr[0][3]); w2.z = cvtpk(gr[1][0], gr[1][1]); w2.w = cvtpk(gr[1][2], gr[1][3]);
                    *(u32x4*)(rowp + 1024) = w2;
                }
        }
    }
};
struct EpiUp {
    static constexpr bool PERM = true, AFTER_DRAIN = false; static constexpr int MIDK = 8;
    const bf16_t* G; bf16_t* MX;
    __device__ __forceinline__ void mid(pg8::f32x4 (&acc)[2][2][4][2], const pg8::Unit& u, int wr, int wc, int fr, int fq) const {
        asm volatile("" : "+v"(fr), "+v"(fq));
        const int row0 = u.pm * 256 + wr * 64 + fr, col0 = u.pn * 256 + wc * 32 + 8 * fq;
#pragma unroll
        for (int ai = 0; ai < 2; ++ai) {
            u32x4 bw[4][2];
#pragma unroll
            for (int m = 0; m < 4; ++m)
#pragma unroll
                for (int bj = 0; bj < 2; ++bj) bw[m][bj] = *(const u32x4*)(G + (size_t)(row0 + ai * 128 + m * 16) * 2048 + 1024 + col0 + bj * 128);
            asm volatile("" ::: "memory");
#pragma unroll
            for (int m = 0; m < 4; ++m)
#pragma unroll
                for (int bj = 0; bj < 2; ++bj) {
                    const u32x4 b_ = bw[m][bj];
                    const f32x4 r0 = {bf_lo(b_.x), bf_hi(b_.x), bf_lo(b_.y), bf_hi(b_.y)}, r1 = {bf_lo(b_.z), bf_hi(b_.z), bf_lo(b_.w), bf_hi(b_.w)};
                    acc[ai][bj][m][0] *= r0; acc[ai][bj][m][1] *= r1;
                }
            asm volatile("" ::: "memory");
        }
    }
    __device__ __forceinline__ void operator()(const pg8::f32x4 (&acc)[2][2][4][2], const pg8::Unit& u, int wr, int wc, int fr, int fq) const {
        asm volatile("" : "+v"(fr), "+v"(fq));
        const int row0 = u.pm * 256 + wr * 64 + fr, col0 = u.pn * 256 + wc * 32 + 8 * fq;
#pragma unroll
        for (int ai = 0; ai < 2; ++ai) {
            u32x4 gw[4][2];
#pragma unroll
            for (int m = 0; m < 4; ++m)
#pragma unroll
                for (int bj = 0; bj < 2; ++bj) gw[m][bj] = *(const u32x4*)(G + (size_t)(row0 + ai * 128 + m * 16) * 2048 + col0 + bj * 128);
            asm volatile("" ::: "memory");
#pragma unroll
            for (int m = 0; m < 4; ++m)
#pragma unroll
                for (int bj = 0; bj < 2; ++bj) {
                    const u32x4 g_ = gw[m][bj];
                    const f32x4 g0 = {bf_lo(g_.x), bf_hi(g_.x), bf_lo(g_.y), bf_hi(g_.y)}, g1 = {bf_lo(g_.z), bf_hi(g_.z), bf_lo(g_.w), bf_hi(g_.w)};
                    const f32x4 v0 = acc[ai][bj][m][0] * g0, v1 = acc[ai][bj][m][1] * g1;
                    u32x4 w; w.x = cvtpk(v0[0], v0[1]); w.y = cvtpk(v0[2], v0[3]); w.z = cvtpk(v1[0], v1[1]); w.w = cvtpk(v1[2], v1[3]);
                    *(u32x4*)(MX + (size_t)(row0 + ai * 128 + m * 16) * DM + col0 + bj * 128) = w;
                }
            asm volatile("" ::: "memory");
        }
    }
};
struct EpiUpA {
    static constexpr bool PERM = true, AFTER_DRAIN = false; static constexpr int MIDK = 0;
    const bf16_t* G; bf16_t* T;
    __device__ __forceinline__ void operator()(const pg8::f32x4 (&acc)[2][2][4][2], const pg8::Unit& u, int wr, int wc, int fr, int fq) const {
        const int row0 = u.pm * 256 + wr * 64 + fr, col0 = u.pn * 256 + wc * 32 + 8 * fq;
#pragma unroll
        for (int ai = 0; ai < 2; ++ai)
#pragma unroll
            for (int m = 0; m < 4; ++m) {
                const int row = row0 + ai * 128 + m * 16;
#pragma unroll
                for (int bj = 0; bj < 2; ++bj) {
                    const int col = col0 + bj * 128;
                    const u32x4 gw = *(const u32x4*)(G + (size_t)row * 2048 + col);
                    const f32x4 g0 = {bf_lo(gw.x), bf_hi(gw.x), bf_lo(gw.y), bf_hi(gw.y)}, g1 = {bf_lo(gw.z), bf_hi(gw.z), bf_lo(gw.w), bf_hi(gw.w)};
                    const f32x4 v0 = acc[ai][bj][m][0] * g0, v1 = acc[ai][bj][m][1] * g1;
                    u32x4 w; w.x = cvtpk(v0[0], v0[1]); w.y = cvtpk(v0[2], v0[3]); w.z = cvtpk(v1[0], v1[1]); w.w = cvtpk(v1[2], v1[3]);
                    *(u32x4*)(T + (size_t)row * DM + col) = w;
                }
                asm volatile("" ::: "memory");
            }
    }
};
struct EpiUpB {
    static constexpr bool PERM = true, AFTER_DRAIN = false; static constexpr int MIDK = 0;
    const bf16_t* G; const bf16_t* T; bf16_t* MX;
    __device__ __forceinline__ void operator()(const pg8::f32x4 (&acc)[2][2][4][2], const pg8::Unit& u, int wr, int wc, int fr, int fq) const {
        const int row0 = u.pm * 256 + wr * 64 + fr, col0 = u.pn * 256 + wc * 32 + 8 * fq;
#pragma unroll
        for (int ai = 0; ai < 2; ++ai)
#pragma unroll
            for (int m = 0; m < 4; ++m) {
                const int row = row0 + ai * 128 + m * 16;
#pragma unroll
                for (int bj = 0; bj < 2; ++bj) {
                    const int col = col0 + bj * 128;
                    const u32x4 gw = *(const u32x4*)(G + (size_t)row * 2048 + 1024 + col);
                    const f32x4 g0 = {bf_lo(gw.x), bf_hi(gw.x), bf_lo(gw.y), bf_hi(gw.y)}, g1 = {bf_lo(gw.z), bf_hi(gw.z), bf_lo(gw.w), bf_hi(gw.w)};
                    const u32x4 tw = *(const u32x4*)(T + (size_t)row * DM + col);
                    const f32x4 t0 = {bf_lo(tw.x), bf_hi(tw.x), bf_lo(tw.y), bf_hi(tw.y)}, t1 = {bf_lo(tw.z), bf_hi(tw.z), bf_lo(tw.w), bf_hi(tw.w)};
                    const f32x4 v0 = t0 + acc[ai][bj][m][0] * g0, v1 = t1 + acc[ai][bj][m][1] * g1;
                    u32x4 w; w.x = cvtpk(v0[0], v0[1]); w.y = cvtpk(v0[2], v0[3]); w.z = cvtpk(v1[0], v1[1]); w.w = cvtpk(v1[2], v1[3]);
                    *(u32x4*)(MX + (size_t)row * DM + col) = w;
                }
                asm volatile("" ::: "memory");
            }
    }
};
struct EpiRes {
    static constexpr bool PERM = false, AFTER_DRAIN = false; static constexpr int MIDK = 0;
    const float* xin; float* out; const float* gmod; int m0; float mul;
    __device__ __forceinline__ void operator()(const pg8::f32x4 (&acc)[2][2][4][2], const pg8::Unit& u, int wr, int wc, int fr, int fq) const {
        const int row0 = u.pm * 256 + wr * 64 + fr, col0 = u.pn * 256 + wc * 32 + 4 * fq;
        const float* gp = gmod + (size_t)batch_of(m0 + u.pm * 256) * NMOD + col0;
        f32x4 gv[2][2];
#pragma unroll
        for (int bj = 0; bj < 2; ++bj)
#pragma unroll
            for (int n = 0; n < 2; ++n) gv[bj][n] = *(const f32x4*)(gp + bj * 128 + n * 16) * mul;
#pragma unroll
        for (int ai = 0; ai < 2; ++ai)
#pragma unroll
            for (int m = 0; m < 4; ++m) {
                const size_t off = (size_t)(row0 + ai * 128 + m * 16) * DM + col0;
#pragma unroll
                for (int bj = 0; bj < 2; ++bj)
#pragma unroll
                    for (int n = 0; n < 2; ++n) { const f32x4 xv = *(const f32x4*)(xin + off + bj * 128 + n * 16); *(f32x4*)(out + off + bj * 128 + n * 16) = xv + gv[bj][n] * acc[ai][bj][m][n]; }
                if (m & 1) asm volatile("" ::: "memory");
            }
    }
};
struct EpiResXs {
    static constexpr bool PERM = false, AFTER_DRAIN = false; static constexpr int MIDK = 0;
    const float* xin; float* out; const float* gmod; const float* ng; const float* scm; bf16_t* XS; float* ssqp; int m0;
    __device__ __forceinline__ void operator()(const pg8::f32x4 (&acc)[2][2][4][2], const pg8::Unit& u, int wr, int wc, int fr, int fq) const {
        const int row0 = u.pm * 256 + wr * 64 + fr, col0 = u.pn * 256 + wc * 32 + 4 * fq;
        const int b = batch_of(m0 + u.pm * 256);
        const float* gp = gmod + (size_t)b * NMOD + col0; const float* scp = scm + (size_t)b * NMOD + col0; const float* ngp = ng + col0;
        f32x4 gv[2][2];
#pragma unroll
        for (int bj = 0; bj < 2; ++bj)
#pragma unroll
            for (int n = 0; n < 2; ++n) gv[bj][n] = *(const f32x4*)(gp + bj * 128 + n * 16);
#pragma unroll
        for (int ai = 0; ai < 2; ++ai)
#pragma unroll
            for (int m = 0; m < 4; ++m) {
                const int row = row0 + ai * 128 + m * 16;
                const size_t off = (size_t)row * DM + col0;
                float ss = 0.f;
#pragma unroll
                for (int bj = 0; bj < 2; ++bj)
#pragma unroll
                    for (int n = 0; n < 2; ++n) {
                        const f32x4 xv = *(const f32x4*)(xin + off + bj * 128 + n * 16);
                        const f32x4 o = xv + gv[bj][n] * acc[ai][bj][m][n];
                        *(f32x4*)(out + off + bj * 128 + n * 16) = o;
                        ss += (o[0] * o[0] + o[1] * o[1]) + (o[2] * o[2] + o[3] * o[3]);
                        const f32x4 cs = *(const f32x4*)(ngp + bj * 128 + n * 16) * (1.0f + *(const f32x4*)(scp + bj * 128 + n * 16));
                        const f32x4 y = o * cs;
                        u32x2 w; w.x = cvtpk(y[0], y[1]); w.y = cvtpk(y[2], y[3]);
                        *(u32x2*)(XS + off + bj * 128 + n * 16) = w;
                    }
                ss += __shfl_xor(ss, 16); ss += __shfl_xor(ss, 32);
                if (fq == 0) ssqp[(size_t)row * 16 + u.pn * 4 + wc] = ss;
                asm volatile("" ::: "memory");
            }
    }
};
struct EpiF1N {
    static constexpr bool PERM = true, AFTER_DRAIN = false; static constexpr int MIDK = 0;
    bf16_t* U; const float* ssqp; const float* bias; int m0;
    __device__ __forceinline__ void operator()(const pg8::f32x4 (&acc)[2][2][4][2], const pg8::Unit& u, int wr, int wc, int fr, int fq) const {
        const int row0 = u.pm * 256 + wr * 64 + fr, col0 = u.pn * 256 + wc * 32 + 8 * fq;
        const float* bp = bias + (size_t)batch_of(m0 + u.pm * 256) * DFF + col0;
        f32x4 bv[2][2];
#pragma unroll
        for (int bj = 0; bj < 2; ++bj)
#pragma unroll
            for (int n = 0; n < 2; ++n) bv[bj][n] = *(const f32x4*)(bp + bj * 128 + n * 4);
#pragma unroll
        for (int ai = 0; ai < 2; ++ai)
#pragma unroll
            for (int m = 0; m < 4; ++m) {
                const int row = row0 + ai * 128 + m * 16;
                const f32x4* sp = (const f32x4*)(ssqp + (size_t)row * 16);
                const f32x4 s4 = (sp[0] + sp[1]) + (sp[2] + sp[3]);
                const float rs = __builtin_amdgcn_rsqf(((s4[0] + s4[1]) + (s4[2] + s4[3])) * (1.0f / DM) + EPS);
                bf16_t* rowp = U + (size_t)row * DFF + col0;
#pragma unroll
                for (int bj = 0; bj < 2; ++bj) {
                    f32x4 v0 = acc[ai][bj][m][0] * rs + bv[bj][0], v1 = acc[ai][bj][m][1] * rs + bv[bj][1];
#pragma unroll
                    for (int e = 0; e < 4; ++e) { const float a = fmaxf(v0[e], 0.f), b = fmaxf(v1[e], 0.f); v0[e] = a * a; v1[e] = b * b; }
                    u32x4 w; w.x = cvtpk(v0[0], v0[1]); w.y = cvtpk(v0[2], v0[3]); w.z = cvtpk(v1[0], v1[1]); w.w = cvtpk(v1[2], v1[3]);
                    *(u32x4*)(rowp + bj * 128) = w;
                }
                asm volatile("" ::: "memory");
            }
    }
};
struct EpiF1 {
    static constexpr bool PERM = true, AFTER_DRAIN = false; static constexpr int MIDK = 0;
    bf16_t* U; int ldc;
    __device__ __forceinline__ void operator()(const pg8::f32x4 (&acc)[2][2][4][2], const pg8::Unit& u, int wr, int wc, int fr, int fq) const {
        const int row0 = u.pm * 256 + wr * 64 + fr, col0 = u.pn * 256 + wc * 32 + 8 * fq;
        const __amdgpu_buffer_rsrc_t rs = __builtin_amdgcn_make_buffer_rsrc((void*)U, (short)0, (int)0x10000000, 0x00020000);
#pragma unroll
        for (int ai = 0; ai < 2; ++ai)
#pragma unroll
            for (int m = 0; m < 4; ++m) {
                const unsigned roff = (unsigned)(((row0 + ai * 128 + m * 16) * ldc + col0) * 2);
#pragma unroll
                for (int bj = 0; bj < 2; ++bj) {
                    f32x4 v0 = acc[ai][bj][m][0], v1 = acc[ai][bj][m][1];
#pragma unroll
                    for (int e = 0; e < 4; ++e) { const float a = fmaxf(v0[e], 0.f), b = fmaxf(v1[e], 0.f); v0[e] = a * a; v1[e] = b * b; }
                    u32x4 w; w.x = cvtpk(v0[0], v0[1]); w.y = cvtpk(v0[2], v0[3]); w.z = cvtpk(v1[0], v1[1]); w.w = cvtpk(v1[2], v1[3]);
                    __builtin_amdgcn_raw_buffer_store_b128(w, rs, roff + bj * 256, 0,   16);
                }
            }
    }
};

struct Args {
    const float *x_prompt, *x_sample, *c_prompt, *c_sample, *norm1_g, *norm2_g, *w_mod, *b_mod, *w_in, *q_norm_g, *k_norm_g, *rel_bias, *rpb, *w_gate, *b_gate,
        *w_up_a, *w_up_b, *w_o, *w_ff1, *w_ff2;
    float* out; unsigned char* ws;
};

__device__ __forceinline__ float wave_sum(float v) {
#pragma unroll
    for (int o = 1; o < 64; o <<= 1) v += __shfl_xor(v, o);
    return v;
}
__device__ __forceinline__ unsigned f2bf(float f) { unsigned u = __builtin_bit_cast(unsigned, f); return (u + 0x7fffu + ((u >> 16) & 1u)) >> 16; }
__device__ __forceinline__ unsigned pk2(float lo, float hi) { return f2bf(lo) | (f2bf(hi) << 16); }

__device__ __forceinline__ void transpose_item(const float* src, int ldn, bf16_t* dst, int K, LAS float* scr, int lane) {
#pragma unroll 8
    for (int i = 0; i < 32; ++i) { const int kk = 2 * i + (lane >> 5); scr[kk * 33 + (lane & 31)] = src[(size_t)kk * ldn + (lane & 31)]; }
    asm volatile("s_waitcnt lgkmcnt(0)" ::: "memory");
    const int c = lane & 7;
#pragma unroll
    for (int j = 0; j < 4; ++j) { const int n = (lane >> 3) + 8 * j; const LAS float* s = scr + (8 * c) * 33 + n;
        u32x4 o; o.x = pk2(s[0 * 33], s[1 * 33]); o.y = pk2(s[2 * 33], s[3 * 33]); o.z = pk2(s[4 * 33], s[5 * 33]); o.w = pk2(s[6 * 33], s[7 * 33]);
        *(u32x4*)(dst + (size_t)n * K + 8 * c) = o; }
    asm volatile("s_waitcnt lgkmcnt(0)" ::: "memory");
}

__device__ __forceinline__ void gemv24_task(const LAS float* cs, const float* wp  , size_t ldw, float* outp  , size_t ldo, const float* badd, int lane) {
    const int ks = lane >> 4;
    float acc[24];
#pragma unroll
    for (int b = 0; b < 24; ++b) acc[b] = 0.f;
#pragma unroll 1
    for (int i0 = 0; i0 < 256; i0 += 16) {
        float wv[16];
#pragma unroll
        for (int ii = 0; ii < 16; ++ii) wv[ii] = wp[(size_t)(4 * (i0 + ii) + ks) * ldw];
#pragma unroll
        for (int ii = 0; ii < 16; ++ii) {
            const int k = 4 * (i0 + ii) + ks; const float w = wv[ii];
            const LAS f32x4* c4 = (const LAS f32x4*)(cs + k * 24);
#pragma unroll
            for (int j = 0; j < 6; ++j) { const f32x4 v = c4[j]; acc[4 * j + 0] += w * v[0]; acc[4 * j + 1] += w * v[1]; acc[4 * j + 2] += w * v[2]; acc[4 * j + 3] += w * v[3]; }
        }
    }
#pragma unroll
    for (int b = 0; b < 24; ++b) { acc[b] += __shfl_xor(acc[b], 16); acc[b] += __shfl_xor(acc[b], 32); }
    if (ks == 0) {
        const float bm = badd ? *badd : 0.f;
#pragma unroll
        for (int b = 0; b < 24; ++b) outp[(size_t)b * ldo] = acc[b] + bm;
    }
}
__device__ __forceinline__ void phase0(const Args& a, LAS unsigned char* lds, int tid, int lane, int wave, int gw, int NGW, int part) {
    float* mod = (float*)(a.ws + WS_MOD);
    bf16_t* W = (bf16_t*)(a.ws + WS_W);
    if (part == 0 || part == 2) {
    LAS float* cs = (LAS float*)lds;
    for (int idx = tid; idx < 24 * 1024; idx += NTHREADS) {
        const int b = idx >> 10, k = idx & 1023;
        const float c = b < 16 ? a.c_prompt[b * 1024 + k] : a.c_sample[(b - 16) * 1024 + k];
        cs[k * 24 + b] = c / (1.0f + __expf(-c));
    }
    __syncthreads();
    for (int t = blockIdx.x + gridDim.x * wave; t < 768; t += NGW) {
        const int l = t / 384, cb = t % 384, col = cb * 16 + (lane & 15);
        gemv24_task(cs, a.w_mod + (size_t)l * 1024 * NMOD + col, NMOD, mod + (size_t)l * 24 * NMOD + col, NMOD, a.b_mod + l * NMOD + col, lane);
    }
    if (part == 0) return;
    __syncthreads();
    }
    if (part == 1) {
    {
        LAS float* cs = (LAS float*)lds;
        const int kind = blockIdx.x % 3, bi = blockIdx.x / 3, nb3 = (gridDim.x - kind + 2) / 3;
        const float* vsrc = (kind < 2) ? mod + (size_t)(kind * 24) * NMOD + 3072 : mod + (size_t)24 * NMOD;
        for (int idx = tid; idx < 24 * 1024; idx += NTHREADS) { const int b = idx >> 10, k = idx & 1023; cs[k * 24 + b] = vsrc[(size_t)b * NMOD + k]; }
        __syncthreads();
        if (kind < 2) {
            float* bf1 = (float*)(a.ws + WS_BF1) + (size_t)kind * 24 * DFF;
            for (int t = bi * NWAVES + wave; t < DFF / 16; t += nb3 * NWAVES) {
                const int col = t * 16 + (lane & 15);
                gemv24_task(cs, a.w_ff1 + (size_t)kind * 1024 * DFF + col, DFF, bf1 + col, DFF, nullptr, lane);
            }
        } else {
            float* bg1 = (float*)(a.ws + WS_BG1);
            for (int t = bi * NWAVES + wave; t < NG1 / 16; t += nb3 * NWAVES) {
                const int col = t * 16 + (lane & 15);
                const float* wp = col < NQKV ? a.w_in + (size_t)1024 * NQKV + col : a.w_gate + (size_t)1024 * 2048 + (col - NQKV);
                gemv24_task(cs, wp, col < NQKV ? NQKV : 2048, bg1 + col, NG1, nullptr, lane);
            }
        }
    }
    __syncthreads();
    }
    LAS float* scr = (LAS float*)(lds + wave * 16384);
    for (int it = gw; it < 2 * 7936; it += NGW) {
        const int l = it / 7936; int r = it % 7936;
        bf16_t* Wl = W + (size_t)l * W_LAYER;
        if (r < 2944) {
            const int kb = r / 184, nb = r % 184, n0 = 32 * nb;
            const int t = n0 & 255, ns = n0 - NQKV;
            const int p0 = n0 < NQKV ? (n0 & ~255) + ((t >> 5) & 1) * 128 + (t >> 6) * 32
                                     : NQKV + ((ns & 1023) >> 7) * 256 + (ns >> 10) * 128 + ((ns & 127) >> 5) * 32;
            const float* src; int ldn;
            if (n0 < NQKV) { src = a.w_in + (size_t)l * 1024 * NQKV + (size_t)(kb * 64) * NQKV + n0; ldn = NQKV; }
            else { src = a.w_gate + (size_t)l * 1024 * 2048 + (size_t)(kb * 64) * 2048 + (n0 - NQKV); ldn = 2048; }
            transpose_item(src, ldn, Wl + W_BT1 + (size_t)p0 * 1024 + kb * 64, 1024, scr, lane);
            continue;
        }
        r -= 2944;
        const float* Wsrc; int Ks, Ns; size_t doff;
        if (r < 128) { const int kb = r / 32, nb = r % 32; transpose_item(a.w_up_a + (size_t)l * 256 * 1024 + (size_t)(kb * 64) * 1024 + nb * 32, 1024, Wl + W_UA + (size_t)(nb * 32) * 768 + 512 + kb * 64, 768, scr, lane); continue; }
        else if ((r -= 128) < 256) { const int kb = r / 32, nb = r % 32; transpose_item(a.w_up_b + (size_t)l * 512 * 1024 + (size_t)(kb * 64) * 1024 + nb * 32, 1024, Wl + W_UA + (size_t)(nb * 32) * 768 + kb * 64, 768, scr, lane); continue; }
        if ((r -= 256) < 512) { Wsrc = a.w_o + (size_t)l * 1024 * 1024; Ks = 1024; Ns = 1024; doff = W_O; }
        else if ((r -= 512) < 2048) { Wsrc = a.w_ff1 + (size_t)l * 1024 * 4096; Ks = 1024; Ns = 4096; doff = W_F1; }
        else { r -= 2048; Wsrc = a.w_ff2 + (size_t)l * 4096 * 1024; Ks = 4096; Ns = 1024; doff = W_F2; }
        const int nblk = Ns / 32, kb = r / nblk, nb = r % nblk;
        transpose_item(Wsrc + (size_t)(kb * 64) * Ns + nb * 32, Ns, Wl + doff + (size_t)(nb * 32) * Ks + kb * 64, Ks, scr, lane);
    }
}

__device__ __forceinline__ void norm_phase(const float* x, bf16_t* H, const float* gvec, const float* modl, int shoff, int m0, int gw, int NGW, int lane) {
    asm volatile("" : "+v"(lane));
    const int per = (MC + NGW - 1) / NGW, r0 = gw * per, r1 = (r0 + per < MC) ? r0 + per : MC;
    int curb = -1; f32x4 csv[4], shv[4];
#pragma unroll
    for (int j = 0; j < 4; ++j) { csv[j] = (f32x4){0.f, 0.f, 0.f, 0.f}; shv[j] = csv[j]; }
    for (int r = r0; r < r1; ++r) {
        const int b = batch_of(m0 + r);
        if (b != curb) {
            curb = b;
            const float* mp = modl + (size_t)b * NMOD + shoff;
#pragma unroll
            for (int j = 0; j < 4; ++j) { const int col = 4 * (64 * j + lane);
                const f32x4 g4 = *(const f32x4*)(gvec + col), sc4 = *(const f32x4*)(mp + 1024 + col);
                csv[j] = g4 * (1.0f + sc4); shv[j] = *(const f32x4*)(mp + col); }
        }
        const f32x4* xr = (const f32x4*)(x + (size_t)r * DM) + lane;
        f32x4 v[4]; float ss = 0.f;
#pragma unroll
        for (int j = 0; j < 4; ++j) { v[j] = xr[64 * j]; ss += (v[j][0] * v[j][0] + v[j][1] * v[j][1]) + (v[j][2] * v[j][2] + v[j][3] * v[j][3]); }
        const float rstd = __builtin_amdgcn_rsqf(wave_sum(ss) * (1.0f / DM) + EPS);
        const __amdgpu_buffer_rsrc_t rsH = __builtin_amdgcn_make_buffer_rsrc((void*)H, (short)0, (int)0x04000000, 0x00020000);
        const unsigned ho = (unsigned)(r * DM * 2 + lane * 8);
#pragma unroll
        for (int j = 0; j < 4; ++j) { const f32x4 y = v[j] * rstd * csv[j] + shv[j]; u32x2 w; w.x = cvtpk(y[0], y[1]); w.y = cvtpk(y[2], y[3]); st8_wt(rsH, ho + 512 * j, w); }
    }
}

struct KV2 { bf16x8 k[2][4]; u32x4 v[2][4]; };
constexpr int WL_V = 0, WL_K = 8192, KSTR = 144, WL_KSUB = 32 * KSTR, WL_TBL = WL_K + 2 * WL_KSUB, WL_BYTES = WL_TBL + 2048;
__device__ __forceinline__ int crow(int r) { return (r & 3) + 8 * (r >> 2); }
__device__ __forceinline__ s16x4 vtr(const LAS unsigned char* p) { typedef short v4i16_t __attribute__((ext_vector_type(4))); return __builtin_bit_cast(s16x4, __builtin_amdgcn_ds_read_tr16_b64_v4i16((LAS v4i16_t*)p)); }

__device__ __forceinline__ void pair_load(KV2& t, const bf16_t* qkv, int rowbase0, int tilestep, int rstride, int head, int nsub, int lane) {
#pragma unroll
    for (int sub = 0; sub < 2; ++sub) if (sub < nsub) {
        const int rowbase = rowbase0 + sub * tilestep;
        const bf16_t* kp = qkv + (size_t)MC * NQ + ((size_t)head * MC + (rowbase + (lane >> 3) * rstride)) * KVROW + (lane & 7) * 8;
#pragma unroll
        for (int i = 0; i < 4; ++i) t.k[sub][i] = *(const bf16x8*)(kp + (8 * i * rstride) * KVROW);
#pragma unroll
        for (int i = 0; i < 4; ++i) t.v[sub][i] = *(const u32x4*)(kp + (8 * i * rstride) * KVROW + 64);
    }
}
__device__ __forceinline__ void pair_stage(const KV2& t, LAS unsigned char* wl, int nsub, int lane) {
#pragma unroll
    for (int sub = 0; sub < 2; ++sub) if (sub < nsub) {
        LAS unsigned char* vd = wl + WL_V + sub * 4096 + ((lane & 7) >> 2) * 2048 + (lane >> 3) * 64 + (lane & 3) * 16;
#pragma unroll
        for (int i = 0; i < 4; ++i) *(LAS u32x4*)(vd + i * 512) = t.v[sub][i];
        LAS unsigned char* kd = wl + WL_K + sub * WL_KSUB + (lane >> 3) * KSTR + (lane & 7) * 16;
#pragma unroll
        for (int i = 0; i < 4; ++i) *(LAS bf16x8*)(kd + i * 8 * KSTR) = t.k[sub][i];
    }
}
__device__ __forceinline__ void q_load(bf16x8 (&qf)[4], const bf16_t* qkv, int row, int head, int lane) {
    const bf16_t* qp = qkv + (size_t)row * NQ + head * 64 + (lane >> 5) * 8;
#pragma unroll
    for (int d0 = 0; d0 < 4; ++d0) qf[d0] = *(const bf16x8*)(qp + 16 * d0);
}
template <class BiasF>
__device__ __forceinline__ void sub_compute(f32x16 (&o)[2], float& lsum, const bf16x8 (&qf)[4], const LAS unsigned char* wl, int sub, int lane, const BiasF& bias) {
    const LAS unsigned char* kb = wl + WL_K + sub * WL_KSUB + (lane & 31) * KSTR + (lane >> 5) * 16;
    bf16x8 kf[4];
#pragma unroll
    for (int d0 = 0; d0 < 4; ++d0) kf[d0] = *(const LAS bf16x8*)(kb + d0 * 32);
    f32x16 s;
#pragma unroll
    for (int r = 0; r < 16; ++r) s[r] = 0.f;
#pragma unroll
    for (int d0 = 0; d0 < 4; ++d0) s = __builtin_amdgcn_mfma_f32_32x32x16_bf16(kf[d0], qf[d0], s, 0, 0, 0);
    float ps = 0.f;
#pragma unroll
    for (int r = 0; r < 16; ++r) { const float e = __builtin_amdgcn_exp2f(s[r] + bias(r)); s[r] = e; ps += e; }
    lsum += ps;
    bf16x8 pf[2];
#pragma unroll
    for (int si = 0; si < 2; ++si) { u32x4 w; w.x = cvtpk(s[8 * si + 0], s[8 * si + 1]); w.y = cvtpk(s[8 * si + 2], s[8 * si + 3]); w.z = cvtpk(s[8 * si + 4], s[8 * si + 5]); w.w = cvtpk(s[8 * si + 6], s[8 * si + 7]);
        pf[si] = __builtin_bit_cast(bf16x8, w); }
    const LAS unsigned char* vr = wl + WL_V + sub * 4096 + (4 * (lane >> 5) + ((lane & 15) >> 2)) * 64 + ((lane >> 4) & 1) * 32 + (lane & 3) * 8;
#pragma unroll
    for (int dt = 0; dt < 2; ++dt)
#pragma unroll
        for (int si = 0; si < 2; ++si) {
            const s16x4 lo = vtr(vr + dt * 2048 + si * 1024), hi4 = vtr(vr + dt * 2048 + si * 1024 + 512);
            const bf16x8 vf = {lo[0], lo[1], lo[2], lo[3], hi4[0], hi4[1], hi4[2], hi4[3]};
            o[dt] = __builtin_amdgcn_mfma_f32_32x32x16_bf16(vf, pf[si], o[dt], 0, 0, 0);
        }
}

__device__ __forceinline__ int t5_bucket(int rel) {
    const int n = rel < 0 ? -rel : rel;
    int v = n;
    if (n >= 8) v = 8 + (n >= 15) + (n >= 27) + (n >= 50) + (n >= 91) + (n >= 166) + (n >= 305) + (n >= 559);
    return (rel > 0 ? 16 : 0) + v;
}

__device__ __forceinline__ void dilated_item(const bf16_t* qkv, bf16_t* OA, float* Oacc, float* Lacc, const float* rel_bias, int s0, int L, int t0, int hh,
                                             LAS unsigned char* wlds, int wave, int lane) {
    LAS float* tbl = (LAS float*)(wlds + WL_TBL);
    const int r32 = lane & 31, hi = lane >> 5;
#pragma unroll 1
    for (int g = 2; g >= 0; --g) {
        const int d = 1 << (2 * g), head = 4 * g + hh, n = L / d;
#pragma unroll
        for (int i = 0; i < 3; ++i) { const int idx = lane + 64 * i, j = idx - 96; const bool ok = (j >= -64) && (j <= 64);
            tbl[idx] = ok ? rel_bias[t5_bucket(d * j) * 12 + head] * LOG2E : NEGB; }
#pragma unroll 1
        for (int tt = 0; tt < 2; ++tt) {
            const int ti = 2 * wave + tt;
            int r, jb;
            if (g == 2) { r = ti; jb = 0; } else if (g == 1) { r = ti & 3; jb = ti >> 2; } else { r = 0; jb = ti; }
            const int p0 = t0 / d + 32 * jb;
            const int qrow = s0 + (p0 + r32) * d + r;
            bf16x8 qf[4]; q_load(qf, qkv, qrow, head, lane);
            f32x16 o[2];
#pragma unroll
            for (int rr = 0; rr < 16; ++rr) { o[0][rr] = 0.f; o[1][rr] = 0.f; }
            float lsum = 0.f;
            int kt_lo = -2, kt_hi = 2;
            if (p0 + 32 * kt_lo < 0) kt_lo = -(p0 / 32);
            if (p0 + 32 * kt_hi >= n) kt_hi = (n - p0) / 32 - 1;
            const int ntile = kt_hi - kt_lo + 1;
            KV2 nx;
            pair_load(nx, qkv, s0 + r * n + p0 + 32 * kt_lo, 32, 1, head, ntile < 2 ? ntile : 2, lane);
            pair_stage(nx, wlds, ntile < 2 ? ntile : 2, lane);
    __builtin_amdgcn_s_waitcnt(0);
            __builtin_amdgcn_s_waitcnt(0);
#pragma unroll 1
            for (int tb = 0; tb < ntile; tb += 2) {
                const int nsub = (ntile - tb) < 2 ? (ntile - tb) : 2, nnext = (ntile - tb - 2) < 2 ? (ntile - tb - 2) : 2;
                if (nnext > 0) pair_load(nx, qkv, s0 + r * n + p0 + 32 * (kt_lo + tb + 2), 32, 1, head, nnext, lane);
#pragma unroll
                for (int sub = 0; sub < 2; ++sub) if (sub < nsub) {
                    const int bbase = 32 * (kt_lo + tb + sub) - r32 + 96 + 4 * hi;
                    sub_compute(o, lsum, qf, wlds, sub, lane, [&](int rr) { return tbl[bbase + crow(rr)]; });
                }
                if (nnext > 0) pair_stage(nx, wlds, nnext, lane);
            }
            float lt = lsum + __shfl_xor(lsum, 32);
            float* oa = Oacc + (size_t)qrow * 256 + hh * 64 + 4 * hi;
            if (g != 2) {
#pragma unroll
                for (int dt = 0; dt < 2; ++dt)
#pragma unroll
                    for (int q4 = 0; q4 < 4; ++q4) { const f32x4 pv = *(const f32x4*)(oa + 32 * dt + 8 * q4);
                        o[dt][4 * q4 + 0] += pv[0]; o[dt][4 * q4 + 1] += pv[1]; o[dt][4 * q4 + 2] += pv[2]; o[dt][4 * q4 + 3] += pv[3]; }
                lt += Lacc[(size_t)qrow * 4 + hh];
            }
            if (g != 0) {
#pragma unroll
                for (int dt = 0; dt < 2; ++dt)
#pragma unroll
                    for (int q4 = 0; q4 < 4; ++q4) *(f32x4*)(oa + 32 * dt + 8 * q4) = (f32x4){o[dt][4 * q4 + 0], o[dt][4 * q4 + 1], o[dt][4 * q4 + 2], o[dt][4 * q4 + 3]};
                if (hi == 0) Lacc[(size_t)qrow * 4 + hh] = lt;
            } else {
                const float inv = 1.0f / lt;
                bf16_t* op = OA + (size_t)qrow * 768 + 512 + hh * 64 + 4 * hi;
#pragma unroll
                for (int dt = 0; dt < 2; ++dt)
#pragma unroll
                    for (int q4 = 0; q4 < 4; ++q4) { u32x2 w; w.x = cvtpk(o[dt][4 * q4 + 0] * inv, o[dt][4 * q4 + 1] * inv); w.y = cvtpk(o[dt][4 * q4 + 2] * inv, o[dt][4 * q4 + 3] * inv);
                        *(u32x2*)(op + 32 * dt + 8 * q4) = w; }
            }
        }
        asm volatile("s_waitcnt vmcnt(0) lgkmcnt(0)" ::: "memory");
        __syncthreads();
    }
}

template <class BiasF>
__device__ __forceinline__ void row_compute(f32x16 (&o)[2], float& lsum, const bf16x8 (&qf)[4], const LAS unsigned char* kb, const LAS unsigned char* vb, const BiasF& bias) {
    bf16x8 kf[4];
#pragma unroll
    for (int d0 = 0; d0 < 4; ++d0) kf[d0] = *(const LAS bf16x8*)(kb + d0 * 32);
    f32x16 s;
#pragma unroll
    for (int r = 0; r < 16; ++r) s[r] = 0.f;
#pragma unroll
    for (int d0 = 0; d0 < 4; ++d0) s = __builtin_amdgcn_mfma_f32_32x32x16_bf16(kf[d0], qf[d0], s, 0, 0, 0);
    float ps = 0.f;
#pragma unroll
    for (int r = 0; r < 16; ++r) { const float e = __builtin_amdgcn_exp2f(s[r] + bias(r)); s[r] = e; ps += e; }
    lsum += ps;
    bf16x8 pf[2];
#pragma unroll
    for (int si = 0; si < 2; ++si) { u32x4 w; w.x = cvtpk(s[8 * si + 0], s[8 * si + 1]); w.y = cvtpk(s[8 * si + 2], s[8 * si + 3]); w.z = cvtpk(s[8 * si + 4], s[8 * si + 5]); w.w = cvtpk(s[8 * si + 6], s[8 * si + 7]);
        pf[si] = __builtin_bit_cast(bf16x8, w); }
#pragma unroll
    for (int dt = 0; dt < 2; ++dt)
#pragma unroll
        for (int si = 0; si < 2; ++si) {
            const s16x4 lo = vtr(vb + dt * 4096 + si * 1024), hi4 = vtr(vb + dt * 4096 + si * 1024 + 512);
            const bf16x8 vf = {lo[0], lo[1], lo[2], lo[3], hi4[0], hi4[1], hi4[2], hi4[3]};
            o[dt] = __builtin_amdgcn_mfma_f32_32x32x16_bf16(vf, pf[si], o[dt], 0, 0, 0);
        }
}

__device__ __forceinline__ void nb_item(const bf16_t* qkv, bf16_t* OB, const float* rpb_lh  , int s0, int L, int tq0, int hb,
                                        LAS unsigned char* lds, int wave, int lane) {
    LAS float* tbl = (LAS float*)(lds + wave * WL_BYTES + WL_TBL);
    const int r32 = lane & 31, hi = lane >> 5, head = 12 + hb, tid = wave * 64 + lane;
#pragma unroll
    for (int i = 0; i < 8; ++i) { const int e = lane + 64 * i, dr = e >> 5, dc = e & 31; tbl[e] = (dr < 15 && dc < 31) ? rpb_lh[dr * 31 + dc] * LOG2E : NEGB; }
    const int rows = L >> 6, rmax = rows - 8;
    const int a0 = tq0 >> 7, a = a0 + (wave >> 2), nblk = wave & 3;
    int kc0 = 16 * nblk - 8; kc0 = kc0 < 0 ? 0 : (kc0 > 32 ? 32 : kc0);
    const int qrowg = 2 * a + (r32 >> 4), qcol = 16 * nblk + (r32 & 15);
    int r_start = qrowg - 4; r_start = r_start < 0 ? 0 : (r_start > rmax ? rmax : r_start);
    int c_start = qcol - 8; c_start = c_start < 0 ? 0 : (c_start > 48 ? 48 : c_start);
    int wlo = 2 * a - 4; wlo = wlo < 0 ? 0 : (wlo > rmax ? rmax : wlo);
    int whi = 2 * a - 3; whi = (whi < 0 ? 0 : (whi > rmax ? rmax : whi)) + 7;
    int blo = 2 * a0 - 4; blo = blo < 0 ? 0 : (blo > rmax ? rmax : blo);
    int bhi = 2 * a0 - 1; bhi = (bhi < 0 ? 0 : (bhi > rmax ? rmax : bhi)) + 7;
    const int nrow = bhi - blo + 1;
    const int qrow = s0 + qrowg * 64 + qcol;
    int coff[16];
#pragma unroll
    for (int rr = 0; rr < 16; ++rr) { const int kcol = kc0 + crow(rr) + 4 * hi; coff[rr] = ((unsigned)(kcol - c_start) < 16u) ? (kcol - qcol + 15) : 31; }
    bf16x8 qf[4]; q_load(qf, qkv, qrow, head, lane);
    f32x16 o[2];
#pragma unroll
    for (int rr = 0; rr < 16; ++rr) { o[0][rr] = 0.f; o[1][rr] = 0.f; }
    float lsum = 0.f;
    const bf16_t* gsrc = qkv + (size_t)MC * NQ + ((size_t)head * MC + s0 + (tid >> 3)) * KVROW + (tid & 7) * 8;
    const int kdst = WL_K + (tid >> 3) * KSTR + (tid & 7) * 16, vdst = ((tid & 7) >> 2) * 4096 + (tid >> 3) * 64 + (tid & 3) * 16;
    const int kfo = WL_K + (kc0 + r32) * KSTR + hi * 16;
    const int vro = (kc0 + 4 * hi + ((lane & 15) >> 2)) * 64 + ((lane >> 4) & 1) * 32 + (lane & 3) * 8;
    bf16x8 pk; u32x4 pv;
    { const bf16_t* g = gsrc + (size_t)blo * 64 * KVROW; pk = *(const bf16x8*)g; pv = *(const u32x4*)(g + 64); }
    *(LAS bf16x8*)(lds + kdst) = pk; *(LAS u32x4*)(lds + vdst) = pv;
    if (nrow > 1) { const bf16_t* g = gsrc + (size_t)(blo + 1) * 64 * KVROW; pk = *(const bf16x8*)g; pv = *(const u32x4*)(g + 64); }
#pragma unroll 1
    for (int t = 0; t < nrow; ++t) {
        const int sl = t % 3, sn = (t + 1) % 3;
        if (t + 1 < nrow) { *(LAS bf16x8*)(lds + sn * WL_BYTES + kdst) = pk; *(LAS u32x4*)(lds + sn * WL_BYTES + vdst) = pv; }
        __syncthreads();
        if (t + 2 < nrow) { const bf16_t* g = gsrc + (size_t)(blo + t + 2) * 64 * KVROW; pk = *(const bf16x8*)g; pv = *(const u32x4*)(g + 64); }
        const int krow = blo + t;
        if (krow >= wlo && krow <= whi) {
            const bool row_ok = (krow >= r_start) && (krow < r_start + 8);
            const LAS float* trow = tbl + (row_ok ? (krow - qrowg + 7) : 15) * 32;
            row_compute(o, lsum, qf, lds + sl * WL_BYTES + kfo, lds + sl * WL_BYTES + vro, [&](int rr) { return trow[coff[rr]]; });
        }
    }
    const float lt = lsum + __shfl_xor(lsum, 32);
    const float inv = 1.0f / lt;
    bf16_t* op = OB + (size_t)qrow * 768 + hb * 64 + 4 * hi;
#pragma unroll
    for (int dt = 0; dt < 2; ++dt)
#pragma unroll
        for (int q4 = 0; q4 < 4; ++q4) { u32x2 w; w.x = cvtpk(o[dt][4 * q4 + 0] * inv, o[dt][4 * q4 + 1] * inv); w.y = cvtpk(o[dt][4 * q4 + 2] * inv, o[dt][4 * q4 + 3] * inv);
            *(u32x2*)(op + 32 * dt + 8 * q4) = w; }
    __syncthreads();
}

__device__ __forceinline__ void attn_phase(const Args& a, int l, int m0, LAS unsigned char* lds, int wave, int lane) {
    asm volatile("" : "+v"(lane));
    const bf16_t* qkv = (const bf16_t*)(a.ws + WS_QKV);
    bf16_t* OA = (bf16_t*)(a.ws + WS_OA); bf16_t* OB = OA;
    float* Oacc = (float*)(a.ws + WS_OACC); float* Lacc = (float*)(a.ws + WS_LACC);
    LAS unsigned char* wlds = lds + wave * WL_BYTES;
    constexpr int NHEAVY = (MC / 512) * 4, NLIGHT = (MC / 256) * 8;
#pragma unroll 1
    for (int it = blockIdx.x; it < NHEAVY + NLIGHT; it += gridDim.x) {
        if (it < NHEAVY) {
            const int hh = it & 3, span = it >> 2, grow = m0 + span * 512;
            int sstart, L;
            if (grow < MP) { sstart = grow & ~2047; L = 2048; } else { sstart = MP + ((grow - MP) & ~8191); L = 8192; }
#ifndef SKIP_HEAVY
            dilated_item(qkv, OA, Oacc, Lacc, a.rel_bias, sstart - m0, L, grow - sstart, hh, wlds, wave, lane);
#endif
        } else {
            const int j = it - NHEAVY, hb = j & 7, grow = m0 + (j >> 3) * 256;
            int sstart, L;
            if (grow < MP) { sstart = grow & ~2047; L = 2048; } else { sstart = MP + ((grow - MP) & ~8191); L = 8192; }
#ifndef SKIP_LIGHT
            nb_item(qkv, OB, a.rpb + (size_t)(l * 8 + hb) * (15 * 31), sstart - m0, L, grow - sstart, hb, lds, wave, lane);
#endif
        }
    }
}

#define RLX_AGENT __ATOMIC_RELAXED, __HIP_MEMORY_SCOPE_AGENT
#define XB_TMO      128
#define XB_XCNT(j)  (256  + 64 * (j))
#define XB_XSUB(j)  (1280 + 64 * (j))
#define XB_XGEN(j)  (2304 + 64 * (j))
#define XB_TOP      3328
#define XB_TOPGEN   3392
#define XCD_BAR_WORDS 3456
#define XB_SPIN_CAP (1u << 18)

__device__ __forceinline__ unsigned xb_ld(unsigned* p)              { return __hip_atomic_load(p, __ATOMIC_RELAXED, __HIP_MEMORY_SCOPE_AGENT); }
__device__ __forceinline__ unsigned xb_add(unsigned* p, unsigned v) { return __hip_atomic_fetch_add(p, v, __ATOMIC_RELAXED, __HIP_MEMORY_SCOPE_AGENT); }
__device__ __forceinline__ unsigned xb_xcc_id() { return (unsigned)__builtin_amdgcn_s_getreg((3 << 11) | 20) & 0xFu; }
#define XB_SPIN(cond, bar) do { unsigned _sp = 0; while (cond) { __builtin_amdgcn_s_sleep(1); \
    if ((++_sp & 255u) == 0u) { if (xb_ld(&(bar)[XB_TMO])) break; if (_sp > XB_SPIN_CAP) { atomicAdd(&(bar)[XB_TMO], 1u); break; } } } } while (0)

struct XcdBarrier {
    unsigned* bar; unsigned x;
    volatile LAS unsigned* st;
};

__device__ __forceinline__ XcdBarrier xcd_barrier_post(unsigned* bar, volatile LAS unsigned* st) {
    XcdBarrier b; b.bar = bar; b.x = xb_xcc_id(); b.st = st;
    if (threadIdx.x == 0) (void)xb_add(&bar[XB_XCNT(b.x)], 1u);
    return b;
}
__device__ __forceinline__ void xcd_barrier_complete(unsigned* bar, unsigned x, unsigned& nloc, unsigned& nx) {
    const unsigned G = gridDim.x * gridDim.y * gridDim.z;
    unsigned sum, cnt, mine, sp = 0u;
    for (;;) {
        sum = 0u; cnt = 0u; mine = 0u;
#pragma unroll
        for (unsigned j = 0; j < 16; ++j) { const unsigned c = xb_ld(&bar[XB_XCNT(j)]); sum += c; cnt += (c > 0u) ? 1u : 0u; mine = (j == x) ? c : mine; }
        if (sum == G) break;
        __builtin_amdgcn_s_sleep(1);
        if ((++sp & 255u) == 0u) { if (xb_ld(&bar[XB_TMO])) break; if (sp > XB_SPIN_CAP) { atomicAdd(&bar[XB_TMO], 1u); break; } }
    }
    nloc = mine > 0u ? mine : 1u; nx = cnt > 0u ? cnt : 1u;
}

__device__ __forceinline__ void xcd_barrier(const XcdBarrier& b) {
    asm volatile("s_waitcnt vmcnt(0)" ::: "memory");
    __syncthreads();
    if (threadIdx.x == 0) {
        unsigned* bar = b.bar;
        __builtin_amdgcn_s_waitcnt(0);
        unsigned nloc = b.st[0], nx = b.st[1];
        if (nloc == 0u) { xcd_barrier_complete(bar, b.x, nloc, nx); b.st[0] = nloc; b.st[1] = nx; }
        const unsigned old = xb_add(&bar[XB_XSUB(b.x)], 1u);
        const unsigned gen = old / nloc;
        if (old + 1u == (gen + 1u) * nloc) {
            __builtin_amdgcn_fence(__ATOMIC_RELEASE, "agent");
            asm volatile("s_waitcnt vmcnt(0)" ::: "memory");
            const unsigned og = xb_add(&bar[XB_TOP], 1u);
            const unsigned tg = og / nx;
            if (og + 1u == (tg + 1u) * nx) xb_add(&bar[XB_TOPGEN], 1u);
            else XB_SPIN(xb_ld(&bar[XB_TOPGEN]) == tg, bar);
            __builtin_amdgcn_fence(__ATOMIC_ACQUIRE, "agent");
            xb_add(&bar[XB_XGEN(b.x)], 1u);
            asm volatile("s_waitcnt vmcnt(0)" ::: "memory");
        } else {
            XB_SPIN(xb_ld(&bar[XB_XGEN(b.x)]) == gen, bar);
            __builtin_amdgcn_fence(__ATOMIC_ACQUIRE, "agent");
            asm volatile("s_waitcnt vmcnt(0)" ::: "memory");
        }
    }
    __syncthreads();
}

#ifndef WO_MUL
#define WO_MUL 1.0f
#endif
#ifndef F2_MUL
#define F2_MUL 1.0f
#endif
#define GEMM_PHASE(EPI, Aptr, Bptr, Nn, Kk, Eobj) do { int K_ = (Kk); asm volatile("" : "+s"(K_)); pg8::Gemm g_{(const pg8::bf16_t*)(Aptr), (const pg8::bf16_t*)(Bptr), MC, (Nn), K_}; pg8::StaticOrder S_; S_.init(MC, (Nn), (int)gridDim.x, (int)blockIdx.x); \
        pg8::gemm_phase<EPI, pg8::StaticOrder, true, true>(lds, g_, S_, (Eobj)); } while (0)

#define GSYNC() xcd_barrier(bar)
__global__ void __launch_bounds__(NTHREADS, 2) mega_fwd(Args a_in) {
    extern __shared__ __attribute__((aligned(16))) unsigned char lds_raw[];
    LAS unsigned char* lds = (LAS unsigned char*)lds_raw;
    cg::grid_group grid = cg::this_grid();
    { volatile LAS unsigned* misc = (volatile LAS unsigned*)(lds + LDS_MISC); if (threadIdx.x < 16) misc[threadIdx.x] = 0u; }
    __syncthreads();
    grid.sync();
    const XcdBarrier bar = xcd_barrier_post((unsigned*)(a_in.ws + WS_CTL), (volatile LAS unsigned*)(lds + LDS_MISC + 32));
#pragma unroll 1
    for (int step = 0; step < 1 + NCHUNK * 16; ++step) {
        const Args& a = a_in;
        int tid = threadIdx.x; asm volatile("" : "+v"(tid));
        const int lane = tid & 63, wave = __builtin_amdgcn_readfirstlane(tid >> 6);
        const int gw = blockIdx.x * NWAVES + wave, NGW = gridDim.x * NWAVES;
        float* mod = (float*)(a.ws + WS_MOD);
        bf16_t* W = (bf16_t*)(a.ws + WS_W);
        bf16_t* H = (bf16_t*)(a.ws + WS_H);
        bf16_t* QKV = (bf16_t*)(a.ws + WS_QKV);
        bf16_t* G = (bf16_t*)(a.ws + WS_G);
        bf16_t* OA = (bf16_t*)(a.ws + WS_OA);
        bf16_t* OB = (bf16_t*)(a.ws + WS_OB);
        bf16_t* T = (bf16_t*)(a.ws + WS_QKV);
        bf16_t* U = (bf16_t*)(a.ws + WS_QKV);
        if (step == 0) {
            phase0(a, lds, tid, lane, wave, gw, NGW, 2);
        } else {
            const int s1 = step - 1, ch = s1 >> 4, l = (s1 >> 3) & 1, ph = s1 & 7;
            const int m0 = ch * MC;
            const float* xin0 = (ch == 0) ? a.x_prompt : a.x_sample + (size_t)(ch - 1) * MC * DM;
            float* xo = a.out + (size_t)m0 * DM;
            const float* xsrc = (l == 0) ? xin0 : (const float*)xo;
            const float* modl = mod + (size_t)l * 24 * NMOD;
            const bf16_t* Wl = W + (size_t)l * W_LAYER;
            if (ph == 0) {
                norm_phase(xsrc, H, a.norm1_g + l * DM, modl, 0, m0, gw, NGW, lane);
            } else if (ph == 1) {
                EpiQKVG E{QKV, G, a.q_norm_g + l * 1280, a.k_norm_g + l * 1280, a.b_gate + l * 2048, m0}; GEMM_PHASE(EpiQKVG, H, Wl + W_BT1, NG1, 1024, E);
            } else if (ph == 2) {
                attn_phase(a, l, m0, lds, wave, lane);
            } else if (ph == 3) {
                { EpiUp E{G, H}; GEMM_PHASE(EpiUp, OA, Wl + W_UA, 1024, 768, E); }
            } else if (ph == 4) {
                EpiRes E{xsrc, xo, modl + 2048, m0, 1.0f}; GEMM_PHASE(EpiRes, H, Wl + W_O, 1024, 1024, E);
            } else if (ph == 5) {
                norm_phase(xo, H, a.norm2_g + l * DM, modl, 3072, m0, gw, NGW, lane);
            } else if (ph == 6) {
                EpiF1 E{U, DFF}; GEMM_PHASE(EpiF1, H, Wl + W_F1, DFF, 1024, E);
            } else {
                EpiRes E{xo, xo, modl + 5120, m0, 1.0f}; GEMM_PHASE(EpiRes, U, Wl + W_F2, 1024, DFF, E);
            }
        }
        GSYNC();
    }
}

extern "C" void kernel_launch(void* const* d_in, const int* in_sizes, int n_in, void* d_out, int out_size, void* d_ws, size_t ws_size, hipStream_t stream) {
    static int grid = 0;
    if (grid == 0) {
        if (n_in != 20 || out_size != M_ALL * DM || ws_size < WS_END) { fprintf(stderr, "kernel_launch: unexpected shapes (n_in %d out %d ws %zu)\n", n_in, out_size, ws_size); grid = -1; return; }
        int dev = 0, cus = 0, per_cu = 0;
        (void)hipGetDevice(&dev);
        (void)hipDeviceGetAttribute(&cus, hipDeviceAttributeMultiprocessorCount, dev);
        if (hipFuncSetAttribute((const void*)mega_fwd, hipFuncAttributeMaxDynamicSharedMemorySize, LDS_BYTES) != hipSuccess) fprintf(stderr, "kernel_launch: hipFuncSetAttribute failed\n");
        if (hipOccupancyMaxActiveBlocksPerMultiprocessor(&per_cu, (const void*)mega_fwd, NTHREADS, LDS_BYTES) != hipSuccess || per_cu < 1) { fprintf(stderr, "kernel_launch: occupancy query says %d\n", per_cu); per_cu = 1; }
        (void)hipGetLastError();
        if (cus <= 0) cus = 256;
        grid = cus * per_cu;
    }
    if (grid < 0) return;
    if (hipMemsetAsync((char*)d_ws + WS_CTL, 0, CTL_BYTES, stream) != hipSuccess) { fprintf(stderr, "kernel_launch: memset failed\n"); return; }
    Args a{};
    const float** ap = (const float**)&a;
    for (int i = 0; i < 20; ++i) ap[i] = (const float*)d_in[i];
    a.out = (float*)d_out; a.ws = (unsigned char*)d_ws;
    void* args[] = {&a};
    hipError_t e = hipLaunchCooperativeKernel((const void*)mega_fwd, dim3(grid), dim3(NTHREADS), args, LDS_BYTES, stream);
    if (e != hipSuccess) fprintf(stderr, "kernel_launch: cooperative launch failed: %s (grid %d)\n", hipGetErrorString(e), grid);
}
```

```cpp
#include <hip/hip_runtime.h>
#include <hip/hip_cooperative_groups.h>
#include <cstdio>
#include <cstdint>
namespace cg = cooperative_groups;
namespace pg8 {
#define PG8_LAS __attribute__((address_space(3)))
typedef unsigned short bf16_t;
typedef short bf16x8 __attribute__((ext_vector_type(8)));
typedef float f32x4 __attribute__((ext_vector_type(4)));
typedef unsigned u32x4 __attribute__((ext_vector_type(4)));
constexpr int BM = 256, BK = 64, HALF = 128, HTB = HALF * BK * 2  , STAGE_BYTES = 8 * HTB, NXCD = 8, WGM = 8;

__host__ __device__ __forceinline__ int lds_byte(int r, int c) { const int st = (r >> 4) * 2 + (c >> 5), rr = r & 15, cc = c & 31, ob = rr * 64 + cc * 2; return st * 1024 + (ob ^ (((ob >> 9) & 1) << 5)); }
__host__ __device__ __forceinline__ void stage_rc(int b, int& R, int& C) { const int st = b / 1024, sb = b % 1024, swz = sb ^ (((sb >> 9) & 1) << 5); R = (st >> 1) * 16 + swz / 64; C = (st & 1) * 32 + (swz % 64) / 2; }
__host__ __device__ __forceinline__ int perm32(int rho) { const int n = rho >> 4, i = rho & 15; return 8 * (i >> 2) + 4 * n + (i & 3); }

struct Unit { int pm, pn; };
struct Gemm { const bf16_t* A; const bf16_t* Bt; int M, N, K; };

struct StaticOrder {
    int nM, nN, nwg, G, c;
    __host__ __device__ void init(int M, int N, int G_, int c_) { nM = M / BM; nN = N / BM; nwg = nM * nN; G = G_; c = c_; }
    __host__ __device__ bool next(int i, Unit& u) const {
        const long L = (long)i * G + c; if (L >= nwg) return false;
        int wgid = (int)L; { const int q = nwg / NXCD, r = nwg % NXCD, xcd = wgid % NXCD, off = wgid / NXCD; wgid = (xcd < r ? xcd * (q + 1) : r * (q + 1) + (xcd - r) * q) + off; }
        const int nig = WGM * nN, gid = wgid / nig, fm = gid * WGM, gsz = (nM - fm) < WGM ? (nM - fm) : WGM;
        u.pm = fm + ((wgid % nig) % gsz); u.pn = (wgid % nig) / gsz; return true;
    }
    __device__ __forceinline__ void a_ready(const Unit&) const {}
    __device__ __forceinline__ void done(const Unit&) const {}
};

__device__ __forceinline__ unsigned cvt_pk_bf16(float lo, float hi) { unsigned r; asm volatile("v_cvt_pk_bf16_f32 %0, %1, %2" : "=v"(r) : "v"(lo), "v"(hi)); return r; }
template <class Epi, class Sched, bool ALIGN_EPI = false, bool SP2 = false>
__device__ __forceinline__ void gemm_phase(PG8_LAS unsigned char* lds, const Gemm g, const Sched& S, const Epi& E) {
    int tid_o = threadIdx.x; asm volatile("" : "+v"(tid_o));
    const int tid = tid_o, wid = __builtin_amdgcn_readfirstlane(tid >> 6), lane = tid & 63, wr = wid >> 2, wc = wid & 3, fr = lane & 15, fq = lane >> 4;
    const int K = g.K, nt = K / BK;
    unsigned voffA[2], voffB[2];
#pragma unroll
    for (int i = 0; i < 2; ++i) { int R, C; stage_rc(tid * 16 + i * 8192, R, C); const int Rb = Epi::PERM ? ((R & ~31) + perm32(R & 31)) : R;
        voffA[i] = (unsigned)(R * K + C) * 2u; voffB[i] = (unsigned)(Rb * K + C) * 2u; }
    const size_t kstep = (size_t)(BK * 2);
    const size_t hstep = (size_t)HALF * K * 2;
    const size_t tstep = 2 * hstep;
    const unsigned ldsw = (unsigned)wid * 1024u;
    const int aoff = lds_byte(wr * 64 + fr, fq * 8), boff = lds_byte(wc * 32 + fr, fq * 8);
#define PG8_SA(b, h) (((b) * 2 + (h)) * HTB)
#define PG8_SB(b, h) ((4 + (b) * 2 + (h)) * HTB)
#define PG8_STAGE(bufoff, gbase, voff) do { _Pragma("unroll") for (int _i = 0; _i < 2; ++_i) \
        __builtin_amdgcn_global_load_lds((const unsigned*)((const char*)(gbase) + (voff)[_i]), (PG8_LAS unsigned*)(lds + (bufoff) + ldsw + _i * 8192), 16, 0, 0); } while (0)
#define PG8_LDA(dst, b, h) do { _Pragma("unroll") for (int m = 0; m < 4; ++m) _Pragma("unroll") for (int k = 0; k < 2; ++k) dst[m][k] = *(const PG8_LAS bf16x8*)(lds + PG8_SA(b, h) + aoff + m * 2048 + k * 1024); } while (0)
#define PG8_LDB(dst, b, h) do { _Pragma("unroll") for (int n = 0; n < 2; ++n) _Pragma("unroll") for (int k = 0; k < 2; ++k) dst[n][k] = *(const PG8_LAS bf16x8*)(lds + PG8_SB(b, h) + boff + n * 2048 + k * 1024); } while (0)
#define PG8_MMA(ai, bj, At, Bt) do { __builtin_amdgcn_s_setprio(1); _Pragma("unroll") for (int m = 0; m < 4; ++m) _Pragma("unroll") for (int n = 0; n < 2; ++n) _Pragma("unroll") for (int k = 0; k < 2; ++k) \
        acc[ai][bj][m][n] = __builtin_amdgcn_mfma_f32_16x16x32_bf16(Bt[n][k], At[m][k], acc[ai][bj][m][n], 0, 0, 0); __builtin_amdgcn_s_setprio(0); } while (0)
#define PG8_WAIT_V(n) asm volatile("s_waitcnt vmcnt(" #n ")" ::: "memory")
#define PG8_WAIT_L(n) asm volatile("s_waitcnt lgkmcnt(" #n ")" ::: "memory")
#define PG8_BAR __builtin_amdgcn_s_barrier()
#define PG8_SCHED __builtin_amdgcn_sched_barrier(0)
    Unit cur, nxt; int ui = 0;
    if (!S.next(0, cur)) return;
    f32x4 acc[2][2][4][2];
#pragma unroll
    for (int a = 0; a < 2; ++a)
#pragma unroll
        for (int b = 0; b < 2; ++b)
#pragma unroll
            for (int m = 0; m < 4; ++m)
#pragma unroll
                for (int n = 0; n < 2; ++n) acc[a][b][m][n] = (f32x4){0.f, 0.f, 0.f, 0.f};
    bf16x8 At[4][2], B0[2][2], B1[2][2];
    const char* cA = (const char*)g.A + (size_t)cur.pm * tstep; const char* cB = (const char*)g.Bt + (size_t)cur.pn * tstep;
    S.a_ready(cur);
    if constexpr (SP2) {
        PG8_STAGE(PG8_SB(0, 0), cB, voffB); PG8_STAGE(PG8_SB(0, 1), cB + hstep, voffB); PG8_STAGE(PG8_SA(0, 0), cA, voffA); PG8_STAGE(PG8_SA(0, 1), cA + hstep, voffA);
        if (wr == 1) PG8_BAR;
        PG8_WAIT_V(2); PG8_BAR;
        PG8_STAGE(PG8_SB(1, 0), cB + kstep, voffB); PG8_STAGE(PG8_SA(1, 0), cA + kstep, voffA); PG8_STAGE(PG8_SB(1, 1), cB + hstep + kstep, voffB);
        PG8_WAIT_V(6); PG8_BAR;
    } else {
        PG8_STAGE(PG8_SB(0, 0), cB, voffB); PG8_STAGE(PG8_SA(0, 0), cA, voffA); PG8_STAGE(PG8_SB(0, 1), cB + hstep, voffB); PG8_STAGE(PG8_SA(0, 1), cA + hstep, voffA);
        if (wr == 1) PG8_BAR;
        PG8_WAIT_V(4); PG8_BAR;
        PG8_STAGE(PG8_SB(1, 0), cB + kstep, voffB); PG8_STAGE(PG8_SA(1, 0), cA + kstep, voffA); PG8_STAGE(PG8_SB(1, 1), cB + hstep + kstep, voffB);
        PG8_WAIT_V(6); PG8_BAR;
    }
    for (;;) {
        const bool has_next = S.next(ui + 1, nxt);
        const char* nA = has_next ? (const char*)g.A + (size_t)nxt.pm * tstep : cA; const char* nB = has_next ? (const char*)g.Bt + (size_t)nxt.pn * tstep : cB;
        for (int t = 0; t < nt; t += 2) {
            if constexpr (Epi::MIDK > 0) { if (t == Epi::MIDK) { __builtin_amdgcn_sched_barrier(0); E.mid(acc, cur, wr, wc, fr, fq); __builtin_amdgcn_sched_barrier(0); } }
            const bool last = (t == nt - 2);
            const char* a1 = cA + (size_t)(t + 1) * kstep;
            const char* a2 = last ? nA : cA + (size_t)(t + 2) * kstep; const char* b2 = last ? nB : cB + (size_t)(t + 2) * kstep;
            const char* a3 = a2 + kstep; const char* b3 = b2 + kstep;
            if (last && has_next) S.a_ready(nxt);
            if constexpr (SP2) {
            PG8_LDB(B0, 0, 0); PG8_LDB(B1, 0, 1); PG8_SCHED; PG8_LDA(At, 0, 0); PG8_STAGE(PG8_SA(1, 1), a1 + hstep, voffA);
            PG8_WAIT_V(8); PG8_WAIT_L(0); PG8_BAR; PG8_MMA(0, 0, At, B0); PG8_MMA(0, 1, At, B1); PG8_BAR; PG8_SCHED;
            PG8_LDA(At, 0, 1); PG8_STAGE(PG8_SB(0, 0), b2, voffB); PG8_STAGE(PG8_SB(0, 1), b2 + hstep, voffB); PG8_STAGE(PG8_SA(0, 0), a2, voffA);
            PG8_WAIT_V(8); PG8_WAIT_L(0); PG8_BAR; PG8_MMA(1, 0, At, B0); PG8_MMA(1, 1, At, B1); PG8_BAR; PG8_SCHED;
            PG8_LDB(B0, 1, 0); PG8_LDB(B1, 1, 1); PG8_SCHED; PG8_LDA(At, 1, 0); PG8_STAGE(PG8_SA(0, 1), a2 + hstep, voffA);
            PG8_WAIT_V(8); PG8_WAIT_L(0); PG8_BAR; PG8_MMA(0, 0, At, B0); PG8_MMA(0, 1, At, B1); PG8_BAR; PG8_SCHED;
            PG8_LDA(At, 1, 1); PG8_STAGE(PG8_SB(1, 0), b3, voffB); PG8_STAGE(PG8_SB(1, 1), b3 + hstep, voffB); PG8_STAGE(PG8_SA(1, 0), a3, voffA);
            PG8_WAIT_V(8); PG8_WAIT_L(0); PG8_BAR; PG8_MMA(1, 0, At, B0); PG8_MMA(1, 1, At, B1); PG8_BAR; PG8_SCHED;
            } else {
            PG8_LDB(B0, 0, 0); PG8_SCHED; PG8_LDA(At, 0, 0); PG8_STAGE(PG8_SA(1, 1), a1 + hstep, voffA);
            PG8_WAIT_L(8); PG8_BAR; PG8_WAIT_L(0); PG8_MMA(0, 0, At, B0); PG8_BAR; PG8_SCHED;
            PG8_LDB(B1, 0, 1); PG8_STAGE(PG8_SB(0, 0), b2, voffB);
            PG8_BAR; PG8_WAIT_L(0); PG8_MMA(0, 1, At, B1); PG8_BAR;
            PG8_LDA(At, 0, 1); PG8_STAGE(PG8_SA(0, 0), a2, voffA);
            PG8_BAR; PG8_WAIT_L(0); PG8_MMA(1, 0, At, B0); PG8_BAR; PG8_SCHED;
            PG8_STAGE(PG8_SB(0, 1), b2 + hstep, voffB);
            PG8_WAIT_V(6); PG8_BAR; PG8_MMA(1, 1, At, B1); PG8_BAR;
            PG8_LDB(B0, 1, 0); PG8_SCHED; PG8_LDA(At, 1, 0); PG8_STAGE(PG8_SA(0, 1), a2 + hstep, voffA);
            PG8_WAIT_L(8); PG8_BAR; PG8_WAIT_L(0); PG8_MMA(0, 0, At, B0); PG8_BAR; PG8_SCHED;
            PG8_LDB(B1, 1, 1); PG8_STAGE(PG8_SB(1, 0), b3, voffB);
            PG8_BAR; PG8_WAIT_L(0); PG8_MMA(0, 1, At, B1); PG8_BAR;
            PG8_LDA(At, 1, 1); PG8_STAGE(PG8_SA(1, 0), a3, voffA);
            PG8_BAR; PG8_WAIT_L(0); PG8_MMA(1, 0, At, B0); PG8_BAR; PG8_SCHED;
            PG8_STAGE(PG8_SB(1, 1), b3 + hstep, voffB);
            PG8_WAIT_V(6); PG8_BAR; PG8_MMA(1, 1, At, B1); PG8_BAR;
            }
        }
        if constexpr (ALIGN_EPI) { if (wr == 0) PG8_BAR; }
        if constexpr (!Epi::AFTER_DRAIN) { E(acc, cur, wr, wc, fr, fq); S.done(cur); }
        if (!has_next) break;
#pragma unroll
        for (int a = 0; a < 2; ++a)
#pragma unroll
            for (int b = 0; b < 2; ++b)
#pragma unroll
                for (int m = 0; m < 4; ++m)
#pragma unroll
                    for (int n = 0; n < 2; ++n) acc[a][b][m][n] = (f32x4){0.f, 0.f, 0.f, 0.f};
        cur = nxt; cA = nA; cB = nB; ++ui;
        if constexpr (ALIGN_EPI) { if (wr == 1) PG8_BAR; }
    }
    PG8_WAIT_V(0);
    if constexpr (!ALIGN_EPI) { if (wr == 0) PG8_BAR; }
    PG8_BAR;
    if constexpr (Epi::AFTER_DRAIN) { E.fused(acc, cur, wr, wc, fr, fq, lds, wid, lane); S.done(cur); }
#undef PG8_SA
#undef PG8_SB
#undef PG8_STAGE
#undef PG8_LDA
#undef PG8_LDB
#undef PG8_MMA
#undef PG8_WAIT_V
#undef PG8_WAIT_L
#undef PG8_BAR
#undef PG8_SCHED
}
}

#define LAS __attribute__((address_space(3)))
typedef unsigned short bf16_t;
typedef short bf16x8 __attribute__((ext_vector_type(8)));
typedef short s16x4 __attribute__((ext_vector_type(4)));
typedef float f32x4 __attribute__((ext_vector_type(4)));
typedef float f32x16 __attribute__((ext_vector_type(16)));
typedef unsigned u32x4 __attribute__((ext_vector_type(4)));
typedef unsigned u32x2 __attribute__((ext_vector_type(2)));

constexpr int DM = 1024, MP = 32768, M_ALL = 98304, NQKV = 3840, NG1 = 5888, DFF = 4096, NMOD = 6144;
constexpr int NQ = 1280, KVROW = 128;
constexpr int NCHUNK = 3, MC = 32768;
constexpr float EPS = 1e-6f, LOG2E = 1.4426950408889634f, QSCALE = 0.125f * LOG2E, NEGB = -1e30f;
constexpr int NWAVES = 8, NTHREADS = 512;
constexpr int LDS_MISC = 155648, LDS_BYTES = 156672;

constexpr size_t W_BT1 = 0, W_UA = 6029312, W_UB = 6291456, W_O = 6815744, W_F1 = 7864320, W_F2 = 12058624, W_LAYER = 16252928;
constexpr size_t MiB = 1u << 20;
constexpr size_t WS_MOD = 0;
constexpr size_t WS_CTL = 1536 * 1024, CTL_BYTES = 16384;
constexpr size_t WS_W = 2 * MiB;
constexpr size_t WS_H = 66 * MiB;
constexpr size_t WS_QKV = 130 * MiB;
constexpr size_t WS_G = 370 * MiB;
constexpr size_t WS_OA = 498 * MiB;
constexpr size_t WS_OB = 514 * MiB;
constexpr size_t WS_OACC = 546 * MiB;
constexpr size_t WS_LACC = 578 * MiB;
constexpr size_t WS_XS = 579 * MiB;
constexpr size_t WS_SSQ = 643 * MiB;
constexpr size_t WS_BF1 = 645 * MiB;
constexpr size_t WS_BG1 = 646 * MiB;
constexpr size_t WS_END = 647 * MiB;

typedef float f32x2_t __attribute__((ext_vector_type(2))); typedef __bf16 bf16x2_t __attribute__((ext_vector_type(2)));
__device__ __forceinline__ unsigned cvtpk(float lo, float hi) { f32x2_t v = {lo, hi}; bf16x2_t b = __builtin_convertvector(v, bf16x2_t); return __builtin_bit_cast(unsigned, b); }
__device__ __forceinline__ float bf_lo(unsigned w) { return __uint_as_float(w << 16); }
__device__ __forceinline__ float bf_hi(unsigned w) { return __uint_as_float(w & 0xffff0000u); }
__device__ __forceinline__ void st8_wt(__amdgpu_buffer_rsrc_t rs, unsigned off, u32x2 v) { __builtin_amdgcn_raw_buffer_store_b64(v, rs, off, 0, 16); }
__device__ __forceinline__ int batch_of(int grow) { return grow < MP ? (grow >> 11) : 16 + ((grow - MP) >> 13); }

__device__ __forceinline__ int kv_srow(int row, int sst, int dsh, int lsh) { const int t = row - sst; return sst + ((t & ((1 << dsh) - 1)) << (lsh - dsh)) + (t >> dsh); }
__device__ __forceinline__ float row_rstd(const float* ssqp, int row) {
    const f32x4* sp = (const f32x4*)(ssqp + (size_t)row * 16);
    const f32x4 s4 = (sp[0] + sp[1]) + (sp[2] + sp[3]);
    return __builtin_amdgcn_rsqf(((s4[0] + s4[1]) + (s4[2] + s4[3])) * (1.0f / DM) + EPS);
}
struct EpiQKVG {
    static constexpr bool PERM = true, AFTER_DRAIN = false; static constexpr int MIDK = 0;
    bf16_t* QKV; bf16_t* G; const float* qg; const float* kg; const float* bgate; int m0;
    __device__ __forceinline__ void operator()(const pg8::f32x4 (&acc)[2][2][4][2], const pg8::Unit& u, int wr, int wc, int fr, int fq) const {
        const int row0 = u.pm * 256 + wr * 64 + fr, pn = u.pn;
        const int lc0 = pn * 256 + wc * 64 + fq * 8;
        const int grow0 = m0 + u.pm * 256;
        const int sst = (grow0 < MP ? (grow0 & ~2047) : MP + ((grow0 - MP) & ~8191)) - m0, lsh = grow0 < MP ? 11 : 13;
        const int hgrp = pn < 10 ? pn - 5 : pn - 10, dsh = hgrp == 1 ? 2 : (hgrp == 2 ? 4 : 0);
#define QKVG_VAL(ai, m, bj, n, rs_) (acc[ai][bj][m][n])
#define QKVG_RS(row_) (1.0f)
#ifdef DIAG_PLAIN_G1
        if (false) {
#else
        if (pn < 10) {
#endif
            const bool isq = pn < 5;
            const int head = (isq ? pn : pn - 5) * 4 + wc;
            const float* gp = (isq ? qg : kg) + head * 64 + fq * 8;
            const float sc = isq ? QSCALE : 1.0f;
            f32x4 gv[2][2];
#pragma unroll
            for (int bj = 0; bj < 2; ++bj)
#pragma unroll
                for (int n = 0; n < 2; ++n) gv[bj][n] = *(const f32x4*)(gp + bj * 32 + n * 4) * sc;
#pragma unroll
            for (int ai = 0; ai < 2; ++ai)
#pragma unroll
                for (int m = 0; m < 4; ++m) {
                    const float rr = QKVG_RS(row0 + ai * 128 + m * 16);
                    f32x4 xv[2][2]; float ss = 0.f;
#pragma unroll
                    for (int bj = 0; bj < 2; ++bj)
#pragma unroll
                        for (int n = 0; n < 2; ++n) { const f32x4 x = QKVG_VAL(ai, m, bj, n, rr); xv[bj][n] = x; ss += (x[0] * x[0] + x[1] * x[1]) + (x[2] * x[2] + x[3] * x[3]); }
                    ss += __shfl_xor(ss, 16); ss += __shfl_xor(ss, 32);
                    const float rs = __builtin_amdgcn_rsqf(ss * (1.0f / 64.0f) + EPS);
                    bf16_t* rowp = isq ? QKV + (size_t)(row0 + ai * 128 + m * 16) * NQ + lc0
                                       : QKV + (size_t)MC * NQ + ((size_t)head * MC + kv_srow(row0 + ai * 128 + m * 16, sst, dsh, lsh)) * KVROW + fq * 8;
#pragma unroll
                    for (int bj = 0; bj < 2; ++bj) {
                        const f32x4 v0 = xv[bj][0] * rs * gv[bj][0], v1 = xv[bj][1] * rs * gv[bj][1];
                        u32x4 w; w.x = cvtpk(v0[0], v0[1]); w.y = cvtpk(v0[2], v0[3]); w.z = cvtpk(v1[0], v1[1]); w.w = cvtpk(v1[2], v1[3]);
                        *(u32x4*)(rowp + bj * 32) = w;
                    }
                    asm volatile("" ::: "memory");
                }
        } else if (pn < 15) {
#pragma unroll
            for (int ai = 0; ai < 2; ++ai)
#pragma unroll
                for (int m = 0; m < 4; ++m) {
                    bf16_t* rowp = QKV + (size_t)MC * NQ + ((size_t)((pn - 10) * 4 + wc) * MC + kv_srow(row0 + ai * 128 + m * 16, sst, dsh, lsh)) * KVROW + 64 + fq * 8;
                    const float rr = QKVG_RS(row0 + ai * 128 + m * 16);
#pragma unroll
                    for (int bj = 0; bj < 2; ++bj) {
                        const f32x4 v0 = QKVG_VAL(ai, m, bj, 0, rr), v1 = QKVG_VAL(ai, m, bj, 1, rr);
                        u32x4 w; w.x = cvtpk(v0[0], v0[1]); w.y = cvtpk(v0[2], v0[3]); w.z = cvtpk(v1[0], v1[1]); w.w = cvtpk(v1[2], v1[3]);
                        *(u32x4*)(rowp + bj * 32) = w;
                    }
                }
        } else {
            const int oc = (pn - 15) * 128 + wc * 32 + fq * 8;
            f32x4 ba[2], bb[2];
#pragma unroll
            for (int n = 0; n < 2; ++n) { ba[n] = *(const f32x4*)(bgate + oc + n * 4); bb[n] = *(const f32x4*)(bgate + 1024 + oc + n * 4); }
#pragma unroll
            for (int ai = 0; ai < 2; ++ai)
#pragma unroll
                for (int m = 0; m < 4; ++m) {
                    bf16_t* rowp = G + (size_t)(row0 + ai * 128 + m * 16) * 2048 + oc;
                    f32x4 ga[2], gr[2];
#pragma unroll
                    for (int n = 0; n < 2; ++n) {
                        const f32x4 xa = acc[ai][0][m][n] + ba[n], xb = acc[ai][1][m][n] + bb[n];
#pragma unroll
                        for (int e = 0; e < 4; ++e) { const float ea = 1.0f + __builtin_amdgcn_exp2f(-LOG2E * xa[e]), eb = 1.0f + __builtin_amdgcn_exp2f(-LOG2E * xb[e]);
                            ga[n][e] = __builtin_amdgcn_rcpf(ea); gr[n][e] = ea * __builtin_amdgcn_rcpf(eb); }
                    }
                    u32x4 w; w.x = cvtpk(ga[0][0], ga[0][1]); w.y = cvtpk(ga[0][2], ga[0][3]); w.z = cvtpk(ga[1][0], ga[1][1]); w.w = cvtpk(ga[1][2], ga[1][3]);
                    *(u32x4*)rowp = w;
                    u32x4 w2; w2.x = cvtpk(gr[0][0], gr[0][1]); w2.y = cvtpk(gr[0][2], gr[0][3]); w2.z = cvtpk(gr[1][0], gr[1][1]); w2.w = cvtpk(gr[1][2], gr[1][3]);
                    *(u32x4*)(rowp + 1024) = w2;
                }
        }
    }
};
struct EpiUp {
    static constexpr bool PERM = true, AFTER_DRAIN = false; static constexpr int MIDK = 8;
    const bf16_t* G; bf16_t* MX;
    __device__ __forceinline__ void mid(pg8::f32x4 (&acc)[2][2][4][2], const pg8::Unit& u, int wr, int wc, int fr, int fq) const {
        asm volatile("" : "+v"(fr), "+v"(fq));
        const int row0 = u.pm * 256 + wr * 64 + fr, col0 = u.pn * 256 + wc * 32 + 8 * fq;
#pragma unroll
        for (int ai = 0; ai < 2; ++ai) {
            u32x4 bw[4][2];
#pragma unroll
            for (int m = 0; m < 4; ++m)
#pragma unroll
                for (int bj = 0; bj < 2; ++bj) bw[m][bj] = *(const u32x4*)(G + (size_t)(row0 + ai * 128 + m * 16) * 2048 + 1024 + col0 + bj * 128);
            asm volatile("" ::: "memory");
#pragma unroll
            for (int m = 0; m < 4; ++m)
#pragma unroll
                for (int bj = 0; bj < 2; ++bj) {
                    const u32x4 b_ = bw[m][bj];
                    const f32x4 r0 = {bf_lo(b_.x), bf_hi(b_.x), bf_lo(b_.y), bf_hi(b_.y)}, r1 = {bf_lo(b_.z), bf_hi(b_.z), bf_lo(b_.w), bf_hi(b_.w)};
                    acc[ai][bj][m][0] *= r0; acc[ai][bj][m][1] *= r1;
                }
            asm volatile("" ::: "memory");
        }
    }
    __device__ __forceinline__ void operator()(const pg8::f32x4 (&acc)[2][2][4][2], const pg8::Unit& u, int wr, int wc, int fr, int fq) const {
        asm volatile("" : "+v"(fr), "+v"(fq));
        const int row0 = u.pm * 256 + wr * 64 + fr, col0 = u.pn * 256 + wc * 32 + 8 * fq;
#pragma unroll
        for (int ai = 0; ai < 2; ++ai) {
            u32x4 gw[4][2];
#pragma unroll
            for (int m = 0; m < 4; ++m)
#pragma unroll
                for (int bj = 0; bj < 2; ++bj) gw[m][bj] = *(const u32x4*)(G + (size_t)(row0 + ai * 128 + m * 16) * 2048 + col0 + bj * 128);
            asm volatile("" ::: "memory");
#pragma unroll
            for (int m = 0; m < 4; ++m)
#pragma unroll
                for (int bj = 0; bj < 2; ++bj) {
                    const u32x4 g_ = gw[m][bj];
                    const f32x4 g0 = {bf_lo(g_.x), bf_hi(g_.x), bf_lo(g_.y), bf_hi(g_.y)}, g1 = {bf_lo(g_.z), bf_hi(g_.z), bf_lo(g_.w), bf_hi(g_.w)};
                    const f32x4 v0 = acc[ai][bj][m][0] * g0, v1 = acc[ai][bj][m][1] * g1;
                    u32x4 w; w.x = cvtpk(v0[0], v0[1]); w.y = cvtpk(v0[2], v0[3]); w.z = cvtpk(v1[0], v1[1]); w.w = cvtpk(v1[2], v1[3]);
                    *(u32x4*)(MX + (size_t)(row0 + ai * 128 + m * 16) * DM + col0 + bj * 128) = w;
                }
            asm volatile("" ::: "memory");
        }
    }
};
struct EpiUpA {
    static constexpr bool PERM = true, AFTER_DRAIN = false; static constexpr int MIDK = 0;
    const bf16_t* G; bf16_t* T;
    __device__ __forceinline__ void operator()(const pg8::f32x4 (&acc)[2][2][4][2], const pg8::Unit& u, int wr, int wc, int fr, int fq) const {
        const int row0 = u.pm * 256 + wr * 64 + fr, col0 = u.pn * 256 + wc * 32 + 8 * fq;
#pragma unroll
        for (int ai = 0; ai < 2; ++ai)
#pragma unroll
            for (int m = 0; m < 4; ++m) {
                const int row = row0 + ai * 128 + m * 16;
#pragma unroll
                for (int bj = 0; bj < 2; ++bj) {
                    const int col = col0 + bj * 128;
                    const u32x4 gw = *(const u32x4*)(G + (size_t)row * 2048 + col);
                    const f32x4 g0 = {bf_lo(gw.x), bf_hi(gw.x), bf_lo(gw.y), bf_hi(gw.y)}, g1 = {bf_lo(gw.z), bf_hi(gw.z), bf_lo(gw.w), bf_hi(gw.w)};
                    const f32x4 v0 = acc[ai][bj][m][0] * g0, v1 = acc[ai][bj][m][1] * g1;
                    u32x4 w; w.x = cvtpk(v0[0], v0[1]); w.y = cvtpk(v0[2], v0[3]); w.z = cvtpk(v1[0], v1[1]); w.w = cvtpk(v1[2], v1[3]);
                    *(u32x4*)(T + (size_t)row * DM + col) = w;
                }
                asm volatile("" ::: "memory");
            }
    }
};
struct EpiUpB {
    static constexpr bool PERM = true, AFTER_DRAIN = false; static constexpr int MIDK = 0;
    const bf16_t* G; const bf16_t* T; bf16_t* MX;
    __device__ __forceinline__ void operator()(const pg8::f32x4 (&acc)[2][2][4][2], const pg8::Unit& u, int wr, int wc, int fr, int fq) const {
        const int row0 = u.pm * 256 + wr * 64 + fr, col0 = u.pn * 256 + wc * 32 + 8 * fq;
#pragma unroll
        for (int ai = 0; ai < 2; ++ai)
#pragma unroll
            for (int m = 0; m < 4; ++m) {
                const int row = row0 + ai * 128 + m * 16;
#pragma unroll
                for (int bj = 0; bj < 2; ++bj) {
                    const int col = col0 + bj * 128;
                    const u32x4 gw = *(const u32x4*)(G + (size_t)row * 2048 + 1024 + col);
                    const f32x4 g0 = {bf_lo(gw.x), bf_hi(gw.x), bf_lo(gw.y), bf_hi(gw.y)}, g1 = {bf_lo(gw.z), bf_hi(gw.z), bf_lo(gw.w), bf_hi(gw.w)};
                    const u32x4 tw = *(const u32x4*)(T + (size_t)row * DM + col);
                    const f32x4 t0 = {bf_lo(tw.x), bf_hi(tw.x), bf_lo(tw.y), bf_hi(tw.y)}, t1 = {bf_lo(tw.z), bf_hi(tw.z), bf_lo(tw.w), bf_hi(tw.w)};
                    const f32x4 v0 = t0 + acc[ai][bj][m][0] * g0, v1 = t1 + acc[ai][bj][m][1] * g1;
                    u32x4 w; w.x = cvtpk(v0[0], v0[1]); w.y = cvtpk(v0[2], v0[3]); w.z = cvtpk(v1[0], v1[1]); w.w = cvtpk(v1[2], v1[3]);
                    *(u32x4*)(MX + (size_t)row * DM + col) = w;
                }
                asm volatile("" ::: "memory");
            }
    }
};
struct EpiRes {
    static constexpr bool PERM = false, AFTER_DRAIN = false; static constexpr int MIDK = 0;
    const float* xin; float* out; const float* gmod; int m0; float mul;
    __device__ __forceinline__ void operator()(const pg8::f32x4 (&acc)[2][2][4][2], const pg8::Unit& u, int wr, int wc, int fr, int fq) const {
        const int row0 = u.pm * 256 + wr * 64 + fr, col0 = u.pn * 256 + wc * 32 + 4 * fq;
        const float* gp = gmod + (size_t)batch_of(m0 + u.pm * 256) * NMOD + col0;
        f32x4 gv[2][2];
#pragma unroll
        for (int bj = 0; bj < 2; ++bj)
#pragma unroll
            for (int n = 0; n < 2; ++n) gv[bj][n] = *(const f32x4*)(gp + bj * 128 + n * 16) * mul;
#pragma unroll
        for (int ai = 0; ai < 2; ++ai)
#pragma unroll
            for (int m = 0; m < 4; ++m) {
                const size_t off = (size_t)(row0 + ai * 128 + m * 16) * DM + col0;
#pragma unroll
                for (int bj = 0; bj < 2; ++bj)
#pragma unroll
                    for (int n = 0; n < 2; ++n) { const f32x4 xv = *(const f32x4*)(xin + off + bj * 128 + n * 16); *(f32x4*)(out + off + bj * 128 + n * 16) = xv + gv[bj][n] * acc[ai][bj][m][n]; }
                if (m & 1) asm volatile("" ::: "memory");
            }
    }
};
struct EpiResXs {
    static constexpr bool PERM = false, AFTER_DRAIN = false; static constexpr int MIDK = 0;
    const float* xin; float* out; const float* gmod; const float* ng; const float* scm; bf16_t* XS; float* ssqp; int m0;
    __device__ __forceinline__ void operator()(const pg8::f32x4 (&acc)[2][2][4][2], const pg8::Unit& u, int wr, int wc, int fr, int fq) const {
        const int row0 = u.pm * 256 + wr * 64 + fr, col0 = u.pn * 256 + wc * 32 + 4 * fq;
        const int b = batch_of(m0 + u.pm * 256);
        const float* gp = gmod + (size_t)b * NMOD + col0; const float* scp = scm + (size_t)b * NMOD + col0; const float* ngp = ng + col0;
        f32x4 gv[2][2];
#pragma unroll
        for (int bj = 0; bj < 2; ++bj)
#pragma unroll
            for (int n = 0; n < 2; ++n) gv[bj][n] = *(const f32x4*)(gp + bj * 128 + n * 16);
#pragma unroll
        for (int ai = 0; ai < 2; ++ai)
#pragma unroll
            for (int m = 0; m < 4; ++m) {
                const int row = row0 + ai * 128 + m * 16;
                const size_t off = (size_t)row * DM + col0;
                float ss = 0.f;
#pragma unroll
                for (int bj = 0; bj < 2; ++bj)
#pragma unroll
                    for (int n = 0; n < 2; ++n) {
                        const f32x4 xv = *(const f32x4*)(xin + off + bj * 128 + n * 16);
                        const f32x4 o = xv + gv[bj][n] * acc[ai][bj][m][n];
                        *(f32x4*)(out + off + bj * 128 + n * 16) = o;
                        ss += (o[0] * o[0] + o[1] * o[1]) + (o[2] * o[2] + o[3] * o[3]);
                        const f32x4 cs = *(const f32x4*)(ngp + bj * 128 + n * 16) * (1.0f + *(const f32x4*)(scp + bj * 128 + n * 16));
                        const f32x4 y = o * cs;
                        u32x2 w; w.x = cvtpk(y[0], y[1]); w.y = cvtpk(y[2], y[3]);
                        *(u32x2*)(XS + off + bj * 128 + n * 16) = w;
                    }
                ss += __shfl_xor(ss, 16); ss += __shfl_xor(ss, 32);
                if (fq == 0) ssqp[(size_t)row * 16 + u.pn * 4 + wc] = ss;
                asm volatile("" ::: "memory");
            }
    }
};
struct EpiF1N {
    static constexpr bool PERM = true, AFTER_DRAIN = false; static constexpr int MIDK = 0;
    bf16_t* U; const float* ssqp; const float* bias; int m0;
    __device__ __forceinline__ void operator()(const pg8::f32x4 (&acc)[2][2][4][2], const pg8::Unit& u, int wr, int wc, int fr, int fq) const {
        const int row0 = u.pm * 256 + wr * 64 + fr, col0 = u.pn * 256 + wc * 32 + 8 * fq;
        const float* bp = bias + (size_t)batch_of(m0 + u.pm * 256) * DFF + col0;
        f32x4 bv[2][2];
#pragma unroll
        for (int bj = 0; bj < 2; ++bj)
#pragma unroll
            for (int n = 0; n < 2; ++n) bv[bj][n] = *(const f32x4*)(bp + bj * 128 + n * 4);
#pragma unroll
        for (int ai = 0; ai < 2; ++ai)
#pragma unroll
            for (int m = 0; m < 4; ++m) {
                const int row = row0 + ai * 128 + m * 16;
                const f32x4* sp = (const f32x4*)(ssqp + (size_t)row * 16);
                const f32x4 s4 = (sp[0] + sp[1]) + (sp[2] + sp[3]);
                const float rs = __builtin_amdgcn_rsqf(((s4[0] + s4[1]) + (s4[2] + s4[3])) * (1.0f / DM) + EPS);
                bf16_t* rowp = U + (size_t)row * DFF + col0;
#pragma unroll
                for (int bj = 0; bj < 2; ++bj) {
                    f32x4 v0 = acc[ai][bj][m][0] * rs + bv[bj][0], v1 = acc[ai][bj][m][1] * rs + bv[bj][1];
#pragma unroll
                    for (int e = 0; e < 4; ++e) { const float a = fmaxf(v0[e], 0.f), b = fmaxf(v1[e], 0.f); v0[e] = a * a; v1[e] = b * b; }
                    u32x4 w; w.x = cvtpk(v0[0], v0[1]); w.y = cvtpk(v0[2], v0[3]); w.z = cvtpk(v1[0], v1[1]); w.w = cvtpk(v1[2], v1[3]);
                    *(u32x4*)(rowp + bj * 128) = w;
                }
                asm volatile("" ::: "memory");
            }
    }
};
struct EpiF1 {
    static constexpr bool PERM = true, AFTER_DRAIN = false; static constexpr int MIDK = 0;
    bf16_t* U; int ldc;
    __device__ __forceinline__ void operator()(const pg8::f32x4 (&acc)[2][2][4][2], const pg8::Unit& u, int wr, int wc, int fr, int fq) const {
        const int row0 = u.pm * 256 + wr * 64 + fr, col0 = u.pn * 256 + wc * 32 + 8 * fq;
        const __amdgpu_buffer_rsrc_t rs = __builtin_amdgcn_make_buffer_rsrc((void*)U, (short)0, (int)0x10000000, 0x00020000);
#pragma unroll
        for (int ai = 0; ai < 2; ++ai)
#pragma unroll
            for (int m = 0; m < 4; ++m) {
                const unsigned roff = (unsigned)(((row0 + ai * 128 + m * 16) * ldc + col0) * 2);
#pragma unroll
                for (int bj = 0; bj < 2; ++bj) {
                    f32x4 v0 = acc[ai][bj][m][0], v1 = acc[ai][bj][m][1];
#pragma unroll
                    for (int e = 0; e < 4; ++e) { const float a = fmaxf(v0[e], 0.f), b = fmaxf(v1[e], 0.f); v0[e] = a * a; v1[e] = b * b; }
                    u32x4 w; w.x = cvtpk(v0[0], v0[1]); w.y = cvtpk(v0[2], v0[3]); w.z = cvtpk(v1[0], v1[1]); w.w = cvtpk(v1[2], v1[3]);
                    __builtin_amdgcn_raw_buffer_store_b128(w, rs, roff + bj * 256, 0,   18);
                }
            }
    }
};

struct Args {
    const float *x_prompt, *x_sample, *c_prompt, *c_sample, *norm1_g, *norm2_g, *w_mod, *b_mod, *w_in, *q_norm_g, *k_norm_g, *rel_bias, *rpb, *w_gate, *b_gate,
        *w_up_a, *w_up_b, *w_o, *w_ff1, *w_ff2;
    float* out; unsigned char* ws;
};

__device__ __forceinline__ float wave_sum(float v) {
#pragma unroll
    for (int o = 1; o < 64; o <<= 1) v += __shfl_xor(v, o);
    return v;
}
__device__ __forceinline__ unsigned f2bf(float f) { unsigned u = __builtin_bit_cast(unsigned, f); return (u + 0x7fffu + ((u >> 16) & 1u)) >> 16; }
__device__ __forceinline__ unsigned pk2(float lo, float hi) { return f2bf(lo) | (f2bf(hi) << 16); }

__device__ __forceinline__ void transpose_item(const float* src, int ldn, bf16_t* dst, int K, LAS float* scr, int lane) {
#pragma unroll 8
    for (int i = 0; i < 32; ++i) { const int kk = 2 * i + (lane >> 5); scr[kk * 33 + (lane & 31)] = src[(size_t)kk * ldn + (lane & 31)]; }
    asm volatile("s_waitcnt lgkmcnt(0)" ::: "memory");
    const int c = lane & 7;
#pragma unroll
    for (int j = 0; j < 4; ++j) { const int n = (lane >> 3) + 8 * j; const LAS float* s = scr + (8 * c) * 33 + n;
        u32x4 o; o.x = pk2(s[0 * 33], s[1 * 33]); o.y = pk2(s[2 * 33], s[3 * 33]); o.z = pk2(s[4 * 33], s[5 * 33]); o.w = pk2(s[6 * 33], s[7 * 33]);
        *(u32x4*)(dst + (size_t)n * K + 8 * c) = o; }
    asm volatile("s_waitcnt lgkmcnt(0)" ::: "memory");
}

__device__ __forceinline__ void gemv24_task(const LAS float* cs, const float* wp  , size_t ldw, float* outp  , size_t ldo, const float* badd, int lane) {
    const int ks = lane >> 4;
    float acc[24];
#pragma unroll
    for (int b = 0; b < 24; ++b) acc[b] = 0.f;
#pragma unroll 1
    for (int i0 = 0; i0 < 256; i0 += 16) {
        float wv[16];
#pragma unroll
        for (int ii = 0; ii < 16; ++ii) wv[ii] = wp[(size_t)(4 * (i0 + ii) + ks) * ldw];
#pragma unroll
        for (int ii = 0; ii < 16; ++ii) {
            const int k = 4 * (i0 + ii) + ks; const float w = wv[ii];
            const LAS f32x4* c4 = (const LAS f32x4*)(cs + k * 24);
#pragma unroll
            for (int j = 0; j < 6; ++j) { const f32x4 v = c4[j]; acc[4 * j + 0] += w * v[0]; acc[4 * j + 1] += w * v[1]; acc[4 * j + 2] += w * v[2]; acc[4 * j + 3] += w * v[3]; }
        }
    }
#pragma unroll
    for (int b = 0; b < 24; ++b) { acc[b] += __shfl_xor(acc[b], 16); acc[b] += __shfl_xor(acc[b], 32); }
    if (ks == 0) {
        const float bm = badd ? *badd : 0.f;
#pragma unroll
        for (int b = 0; b < 24; ++b) outp[(size_t)b * ldo] = acc[b] + bm;
    }
}
__device__ __forceinline__ void phase0(const Args& a, LAS unsigned char* lds, int tid, int lane, int wave, int gw, int NGW, int part) {
    float* mod = (float*)(a.ws + WS_MOD);
    bf16_t* W = (bf16_t*)(a.ws + WS_W);
    if (part == 0 || part == 2) {
    LAS float* cs = (LAS float*)lds;
    for (int idx = tid; idx < 24 * 1024; idx += NTHREADS) {
        const int b = idx >> 10, k = idx & 1023;
        const float c = b < 16 ? a.c_prompt[b * 1024 + k] : a.c_sample[(b - 16) * 1024 + k];
        cs[k * 24 + b] = c / (1.0f + __expf(-c));
    }
    __syncthreads();
    for (int t = blockIdx.x + gridDim.x * wave; t < 768; t += NGW) {
        const int l = t / 384, cb = t % 384, col = cb * 16 + (lane & 15);
        gemv24_task(cs, a.w_mod + (size_t)l * 1024 * NMOD + col, NMOD, mod + (size_t)l * 24 * NMOD + col, NMOD, a.b_mod + l * NMOD + col, lane);
    }
    if (part == 0) return;
    __syncthreads();
    }
    if (part == 1) {
    {
        LAS float* cs = (LAS float*)lds;
        const int kind = blockIdx.x % 3, bi = blockIdx.x / 3, nb3 = (gridDim.x - kind + 2) / 3;
        const float* vsrc = (kind < 2) ? mod + (size_t)(kind * 24) * NMOD + 3072 : mod + (size_t)24 * NMOD;
        for (int idx = tid; idx < 24 * 1024; idx += NTHREADS) { const int b = idx >> 10, k = idx & 1023; cs[k * 24 + b] = vsrc[(size_t)b * NMOD + k]; }
        __syncthreads();
        if (kind < 2) {
            float* bf1 = (float*)(a.ws + WS_BF1) + (size_t)kind * 24 * DFF;
            for (int t = bi * NWAVES + wave; t < DFF / 16; t += nb3 * NWAVES) {
                const int col = t * 16 + (lane & 15);
                gemv24_task(cs, a.w_ff1 + (size_t)kind * 1024 * DFF + col, DFF, bf1 + col, DFF, nullptr, lane);
            }
        } else {
            float* bg1 = (float*)(a.ws + WS_BG1);
            for (int t = bi * NWAVES + wave; t < NG1 / 16; t += nb3 * NWAVES) {
                const int col = t * 16 + (lane & 15);
                const float* wp = col < NQKV ? a.w_in + (size_t)1024 * NQKV + col : a.w_gate + (size_t)1024 * 2048 + (col - NQKV);
                gemv24_task(cs, wp, col < NQKV ? NQKV : 2048, bg1 + col, NG1, nullptr, lane);
            }
        }
    }
    __syncthreads();
    }
    LAS float* scr = (LAS float*)(lds + wave * 16384);
    for (int it = gw; it < 2 * 7936; it += NGW) {
        const int l = it / 7936; int r = it % 7936;
        bf16_t* Wl = W + (size_t)l * W_LAYER;
        if (r < 2944) {
            const int kb = r / 184, nb = r % 184, n0 = 32 * nb;
            const int t = n0 & 255, ns = n0 - NQKV;
            const int p0 = n0 < NQKV ? (n0 & ~255) + ((t >> 5) & 1) * 128 + (t >> 6) * 32
                                     : NQKV + ((ns & 1023) >> 7) * 256 + (ns >> 10) * 128 + ((ns & 127) >> 5) * 32;
            const float* src; int ldn;
            if (n0 < NQKV) { src = a.w_in + (size_t)l * 1024 * NQKV + (size_t)(kb * 64) * NQKV + n0; ldn = NQKV; }
            else { src = a.w_gate + (size_t)l * 1024 * 2048 + (size_t)(kb * 64) * 2048 + (n0 - NQKV); ldn = 2048; }
            transpose_item(src, ldn, Wl + W_BT1 + (size_t)p0 * 1024 + kb * 64, 1024, scr, lane);
            continue;
        }
        r -= 2944;
        const float* Wsrc; int Ks, Ns; size_t doff;
        if (r < 128) { const int kb = r / 32, nb = r % 32; transpose_item(a.w_up_a + (size_t)l * 256 * 1024 + (size_t)(kb * 64) * 1024 + nb * 32, 1024, Wl + W_UA + (size_t)(nb * 32) * 768 + 512 + kb * 64, 768, scr, lane); continue; }
        else if ((r -= 128) < 256) { const int kb = r / 32, nb = r % 32; transpose_item(a.w_up_b + (size_t)l * 512 * 1024 + (size_t)(kb * 64) * 1024 + nb * 32, 1024, Wl + W_UA + (size_t)(nb * 32) * 768 + kb * 64, 768, scr, lane); continue; }
        if ((r -= 256) < 512) { Wsrc = a.w_o + (size_t)l * 1024 * 1024; Ks = 1024; Ns = 1024; doff = W_O; }
        else if ((r -= 512) < 2048) { Wsrc = a.w_ff1 + (size_t)l * 1024 * 4096; Ks = 1024; Ns = 4096; doff = W_F1; }
        else { r -= 2048; Wsrc = a.w_ff2 + (size_t)l * 4096 * 1024; Ks = 4096; Ns = 1024; doff = W_F2; }
        const int nblk = Ns / 32, kb = r / nblk, nb = r % nblk;
        transpose_item(Wsrc + (size_t)(kb * 64) * Ns + nb * 32, Ns, Wl + doff + (size_t)(nb * 32) * Ks + kb * 64, Ks, scr, lane);
    }
}

__device__ __forceinline__ void norm_phase(const float* x, bf16_t* H, const float* gvec, const float* modl, int shoff, int m0, int gw, int NGW, int lane) {
    asm volatile("" : "+v"(lane));
    const int per = (MC + NGW - 1) / NGW, r0 = gw * per, r1 = (r0 + per < MC) ? r0 + per : MC;
    int curb = -1; f32x4 csv[4], shv[4];
#pragma unroll
    for (int j = 0; j < 4; ++j) { csv[j] = (f32x4){0.f, 0.f, 0.f, 0.f}; shv[j] = csv[j]; }
    for (int r = r0; r < r1; ++r) {
        const int b = batch_of(m0 + r);
        if (b != curb) {
            curb = b;
            const float* mp = modl + (size_t)b * NMOD + shoff;
#pragma unroll
            for (int j = 0; j < 4; ++j) { const int col = 4 * (64 * j + lane);
                const f32x4 g4 = *(const f32x4*)(gvec + col), sc4 = *(const f32x4*)(mp + 1024 + col);
                csv[j] = g4 * (1.0f + sc4); shv[j] = *(const f32x4*)(mp + col); }
        }
        const f32x4* xr = (const f32x4*)(x + (size_t)r * DM) + lane;
        f32x4 v[4]; float ss = 0.f;
#pragma unroll
        for (int j = 0; j < 4; ++j) { v[j] = xr[64 * j]; ss += (v[j][0] * v[j][0] + v[j][1] * v[j][1]) + (v[j][2] * v[j][2] + v[j][3] * v[j][3]); }
        const float rstd = __builtin_amdgcn_rsqf(wave_sum(ss) * (1.0f / DM) + EPS);
        const __amdgpu_buffer_rsrc_t rsH = __builtin_amdgcn_make_buffer_rsrc((void*)H, (short)0, (int)0x04000000, 0x00020000);
        const unsigned ho = (unsigned)(r * DM * 2 + lane * 8);
#pragma unroll
        for (int j = 0; j < 4; ++j) { const f32x4 y = v[j] * rstd * csv[j] + shv[j]; u32x2 w; w.x = cvtpk(y[0], y[1]); w.y = cvtpk(y[2], y[3]); st8_wt(rsH, ho + 512 * j, w); }
    }
}

struct KV2 { bf16x8 k[2][4]; u32x4 v[2][4]; };
constexpr int WL_V = 0, WL_K = 8192, KSTR = 144, WL_KSUB = 32 * KSTR, WL_TBL = WL_K + 2 * WL_KSUB, WL_BYTES = WL_TBL + 2048;
__device__ __forceinline__ int crow(int r) { return (r & 3) + 8 * (r >> 2); }
__device__ __forceinline__ s16x4 vtr(const LAS unsigned char* p) { typedef short v4i16_t __attribute__((ext_vector_type(4))); return __builtin_bit_cast(s16x4, __builtin_amdgcn_ds_read_tr16_b64_v4i16((LAS v4i16_t*)p)); }

__device__ __forceinline__ void pair_load(KV2& t, const bf16_t* qkv, int rowbase0, int tilestep, int rstride, int head, int nsub, int lane) {
#pragma unroll
    for (int sub = 0; sub < 2; ++sub) if (sub < nsub) {
        const int rowbase = rowbase0 + sub * tilestep;
        const bf16_t* kp = qkv + (size_t)MC * NQ + ((size_t)head * MC + (rowbase + (lane >> 3) * rstride)) * KVROW + (lane & 7) * 8;
#pragma unroll
        for (int i = 0; i < 4; ++i) t.k[sub][i] = *(const bf16x8*)(kp + (8 * i * rstride) * KVROW);
#pragma unroll
        for (int i = 0; i < 4; ++i) t.v[sub][i] = *(const u32x4*)(kp + (8 * i * rstride) * KVROW + 64);
    }
}
__device__ __forceinline__ void pair_stage(const KV2& t, LAS unsigned char* wl, int nsub, int lane) {
#pragma unroll
    for (int sub = 0; sub < 2; ++sub) if (sub < nsub) {
        LAS unsigned char* vd = wl + WL_V + sub * 4096 + ((lane & 7) >> 2) * 2048 + (lane >> 3) * 64 + (lane & 3) * 16;
#pragma unroll
        for (int i = 0; i < 4; ++i) *(LAS u32x4*)(vd + i * 512) = t.v[sub][i];
        LAS unsigned char* kd = wl + WL_K + sub * WL_KSUB + (lane >> 3) * KSTR + (lane & 7) * 16;
#pragma unroll
        for (int i = 0; i < 4; ++i) *(LAS bf16x8*)(kd + i * 8 * KSTR) = t.k[sub][i];
    }
}
__device__ __forceinline__ void q_load(bf16x8 (&qf)[4], const bf16_t* qkv, int row, int head, int lane) {
    const bf16_t* qp = qkv + (size_t)row * NQ + head * 64 + (lane >> 5) * 8;
#pragma unroll
    for (int d0 = 0; d0 < 4; ++d0) qf[d0] = *(const bf16x8*)(qp + 16 * d0);
}
template <class BiasF>
__device__ __forceinline__ void sub_compute(f32x16 (&o)[2], float& lsum, const bf16x8 (&qf)[4], const LAS unsigned char* wl, int sub, int lane, const BiasF& bias) {
    const LAS unsigned char* kb = wl + WL_K + sub * WL_KSUB + (lane & 31) * KSTR + (lane >> 5) * 16;
    bf16x8 kf[4];
#pragma unroll
    for (int d0 = 0; d0 < 4; ++d0) kf[d0] = *(const LAS bf16x8*)(kb + d0 * 32);
    f32x16 s;
#pragma unroll
    for (int r = 0; r < 16; ++r) s[r] = 0.f;
#pragma unroll
    for (int d0 = 0; d0 < 4; ++d0) s = __builtin_amdgcn_mfma_f32_32x32x16_bf16(kf[d0], qf[d0], s, 0, 0, 0);
    float ps = 0.f;
#pragma unroll
    for (int r = 0; r < 16; ++r) { const float e = __builtin_amdgcn_exp2f(s[r] + bias(r)); s[r] = e; ps += e; }
    lsum += ps;
    bf16x8 pf[2];
#pragma unroll
    for (int si = 0; si < 2; ++si) { u32x4 w; w.x = cvtpk(s[8 * si + 0], s[8 * si + 1]); w.y = cvtpk(s[8 * si + 2], s[8 * si + 3]); w.z = cvtpk(s[8 * si + 4], s[8 * si + 5]); w.w = cvtpk(s[8 * si + 6], s[8 * si + 7]);
        pf[si] = __builtin_bit_cast(bf16x8, w); }
    const LAS unsigned char* vr = wl + WL_V + sub * 4096 + (4 * (lane >> 5) + ((lane & 15) >> 2)) * 64 + ((lane >> 4) & 1) * 32 + (lane & 3) * 8;
#pragma unroll
    for (int dt = 0; dt < 2; ++dt)
#pragma unroll
        for (int si = 0; si < 2; ++si) {
            const s16x4 lo = vtr(vr + dt * 2048 + si * 1024), hi4 = vtr(vr + dt * 2048 + si * 1024 + 512);
            const bf16x8 vf = {lo[0], lo[1], lo[2], lo[3], hi4[0], hi4[1], hi4[2], hi4[3]};
            o[dt] = __builtin_amdgcn_mfma_f32_32x32x16_bf16(vf, pf[si], o[dt], 0, 0, 0);
        }
}

__device__ __forceinline__ int t5_bucket(int rel) {
    const int n = rel < 0 ? -rel : rel;
    int v = n;
    if (n >= 8) v = 8 + (n >= 15) + (n >= 27) + (n >= 50) + (n >= 91) + (n >= 166) + (n >= 305) + (n >= 559);
    return (rel > 0 ? 16 : 0) + v;
}

__device__ __forceinline__ void dilated_item(const bf16_t* qkv, bf16_t* OA, float* Oacc, float* Lacc, const float* rel_bias, int s0, int L, int t0, int hh,
                                             LAS unsigned char* wlds, int wave, int lane) {
    LAS float* tbl = (LAS float*)(wlds + WL_TBL);
    const int r32 = lane & 31, hi = lane >> 5;
#pragma unroll 1
    for (int g = 2; g >= 0; --g) {
        const int d = 1 << (2 * g), head = 4 * g + hh, n = L / d;
#pragma unroll
        for (int i = 0; i < 3; ++i) { const int idx = lane + 64 * i, j = idx - 96; const bool ok = (j >= -64) && (j <= 64);
            tbl[idx] = ok ? rel_bias[t5_bucket(d * j) * 12 + head] * LOG2E : NEGB; }
#pragma unroll 1
        for (int tt = 0; tt < 2; ++tt) {
            const int ti = 2 * wave + tt;
            int r, jb;
            if (g == 2) { r = ti; jb = 0; } else if (g == 1) { r = ti & 3; jb = ti >> 2; } else { r = 0; jb = ti; }
            const int p0 = t0 / d + 32 * jb;
            const int qrow = s0 + (p0 + r32) * d + r;
            bf16x8 qf[4]; q_load(qf, qkv, qrow, head, lane);
            f32x16 o[2];
#pragma unroll
            for (int rr = 0; rr < 16; ++rr) { o[0][rr] = 0.f; o[1][rr] = 0.f; }
            float lsum = 0.f;
            int kt_lo = -2, kt_hi = 2;
            if (p0 + 32 * kt_lo < 0) kt_lo = -(p0 / 32);
            if (p0 + 32 * kt_hi >= n) kt_hi = (n - p0) / 32 - 1;
            const int ntile = kt_hi - kt_lo + 1;
            KV2 nx;
            pair_load(nx, qkv, s0 + r * n + p0 + 32 * kt_lo, 32, 1, head, ntile < 2 ? ntile : 2, lane);
            pair_stage(nx, wlds, ntile < 2 ? ntile : 2, lane);
    __builtin_amdgcn_s_waitcnt(0);
            __builtin_amdgcn_s_waitcnt(0);
#pragma unroll 1
            for (int tb = 0; tb < ntile; tb += 2) {
                const int nsub = (ntile - tb) < 2 ? (ntile - tb) : 2, nnext = (ntile - tb - 2) < 2 ? (ntile - tb - 2) : 2;
                if (nnext > 0) pair_load(nx, qkv, s0 + r * n + p0 + 32 * (kt_lo + tb + 2), 32, 1, head, nnext, lane);
#pragma unroll
                for (int sub = 0; sub < 2; ++sub) if (sub < nsub) {
                    const int bbase = 32 * (kt_lo + tb + sub) - r32 + 96 + 4 * hi;
                    sub_compute(o, lsum, qf, wlds, sub, lane, [&](int rr) { return tbl[bbase + crow(rr)]; });
                }
                if (nnext > 0) pair_stage(nx, wlds, nnext, lane);
            }
            float lt = lsum + __shfl_xor(lsum, 32);
            float* oa = Oacc + (size_t)qrow * 256 + hh * 64 + 4 * hi;
            if (g != 2) {
#pragma unroll
                for (int dt = 0; dt < 2; ++dt)
#pragma unroll
                    for (int q4 = 0; q4 < 4; ++q4) { const f32x4 pv = *(const f32x4*)(oa + 32 * dt + 8 * q4);
                        o[dt][4 * q4 + 0] += pv[0]; o[dt][4 * q4 + 1] += pv[1]; o[dt][4 * q4 + 2] += pv[2]; o[dt][4 * q4 + 3] += pv[3]; }
                lt += Lacc[(size_t)qrow * 4 + hh];
            }
            if (g != 0) {
#pragma unroll
                for (int dt = 0; dt < 2; ++dt)
#pragma unroll
                    for (int q4 = 0; q4 < 4; ++q4) *(f32x4*)(oa + 32 * dt + 8 * q4) = (f32x4){o[dt][4 * q4 + 0], o[dt][4 * q4 + 1], o[dt][4 * q4 + 2], o[dt][4 * q4 + 3]};
                if (hi == 0) Lacc[(size_t)qrow * 4 + hh] = lt;
            } else {
                const float inv = 1.0f / lt;
                bf16_t* op = OA + (size_t)qrow * 768 + 512 + hh * 64 + 4 * hi;
#pragma unroll
                for (int dt = 0; dt < 2; ++dt)
#pragma unroll
                    for (int q4 = 0; q4 < 4; ++q4) { u32x2 w; w.x = cvtpk(o[dt][4 * q4 + 0] * inv, o[dt][4 * q4 + 1] * inv); w.y = cvtpk(o[dt][4 * q4 + 2] * inv, o[dt][4 * q4 + 3] * inv);
                        *(u32x2*)(op + 32 * dt + 8 * q4) = w; }
            }
        }
        asm volatile("s_waitcnt vmcnt(0) lgkmcnt(0)" ::: "memory");
        __syncthreads();
    }
}

__device__ __forceinline__ void nb_item(const bf16_t* qkv, bf16_t* OB, const float* rpb_lh  , int s0, int L, int tq0, int hb,
                                        LAS unsigned char* wlds, int wave, int lane) {
    LAS float* tbl = (LAS float*)(wlds + WL_TBL);
    const int r32 = lane & 31, hi = lane >> 5, head = 12 + hb;
#pragma unroll
    for (int i = 0; i < 8; ++i) { const int e = lane + 64 * i, dr = e >> 5, dc = e & 31; tbl[e] = (dr < 15 && dc < 31) ? rpb_lh[dr * 31 + dc] * LOG2E : NEGB; }
    const int rows = L >> 6;
    const int a = (tq0 >> 7) + (wave >> 2), nblk = wave & 3;
    int band = 2 * a - 4; band = band < 0 ? 0 : (band > rows - 10 ? rows - 10 : band);
    int kc0 = 16 * nblk - 8; kc0 = kc0 < 0 ? 0 : (kc0 > 32 ? 32 : kc0);
    const int qrowg = 2 * a + (r32 >> 4), qcol = 16 * nblk + (r32 & 15);
    int r_start = qrowg - 4; r_start = r_start < 0 ? 0 : (r_start > rows - 8 ? rows - 8 : r_start);
    int c_start = qcol - 8; c_start = c_start < 0 ? 0 : (c_start > 48 ? 48 : c_start);
    int rs0 = 2 * a - 4; rs0 = rs0 < 0 ? 0 : (rs0 > rows - 8 ? rows - 8 : rs0);
    int rs1 = 2 * a - 3; rs1 = rs1 < 0 ? 0 : (rs1 > rows - 8 ? rows - 8 : rs1);
    int kr_lo = rs0 - band, kr_hi = rs1 + 7 - band;
    kr_lo = kr_lo < 0 ? 0 : kr_lo; kr_hi = kr_hi > 9 ? 9 : kr_hi;
    const int qrow = s0 + qrowg * 64 + qcol;
    int coff[16];
#pragma unroll
    for (int rr = 0; rr < 16; ++rr) { const int kcol = kc0 + crow(rr) + 4 * hi; coff[rr] = ((unsigned)(kcol - c_start) < 16u) ? (kcol - qcol + 15) : 31; }
    bf16x8 qf[4]; q_load(qf, qkv, qrow, head, lane);
    f32x16 o[2];
#pragma unroll
    for (int rr = 0; rr < 16; ++rr) { o[0][rr] = 0.f; o[1][rr] = 0.f; }
    float lsum = 0.f;
    const int ntile = kr_hi - kr_lo + 1;
    KV2 nx;
    pair_load(nx, qkv, s0 + (band + kr_lo) * 64 + kc0, 64, 1, head, ntile < 2 ? ntile : 2, lane);
    pair_stage(nx, wlds, ntile < 2 ? ntile : 2, lane);
    __builtin_amdgcn_s_waitcnt(0);
#pragma unroll 1
    for (int tb = 0; tb < ntile; tb += 2) {
        const int nsub = (ntile - tb) < 2 ? (ntile - tb) : 2, nnext = (ntile - tb - 2) < 2 ? (ntile - tb - 2) : 2;
        if (nnext > 0) pair_load(nx, qkv, s0 + (band + kr_lo + tb + 2) * 64 + kc0, 64, 1, head, nnext, lane);
#pragma unroll
        for (int sub = 0; sub < 2; ++sub) if (sub < nsub) {
            const int krow = band + kr_lo + tb + sub;
            const bool row_ok = (krow >= r_start) && (krow < r_start + 8);
            const LAS float* trow = tbl + (row_ok ? (krow - qrowg + 7) : 15) * 32;
            sub_compute(o, lsum, qf, wlds, sub, lane, [&](int rr) { return trow[coff[rr]]; });
        }
        if (nnext > 0) pair_stage(nx, wlds, nnext, lane);
    }
    const float lt = lsum + __shfl_xor(lsum, 32);
    const float inv = 1.0f / lt;
    bf16_t* op = OB + (size_t)qrow * 768 + hb * 64 + 4 * hi;
#pragma unroll
    for (int dt = 0; dt < 2; ++dt)
#pragma unroll
        for (int q4 = 0; q4 < 4; ++q4) { u32x2 w; w.x = cvtpk(o[dt][4 * q4 + 0] * inv, o[dt][4 * q4 + 1] * inv); w.y = cvtpk(o[dt][4 * q4 + 2] * inv, o[dt][4 * q4 + 3] * inv);
            *(u32x2*)(op + 32 * dt + 8 * q4) = w; }
    asm volatile("s_waitcnt lgkmcnt(0)" ::: "memory");
}

__device__ __forceinline__ void attn_phase(const Args& a, int l, int m0, LAS unsigned char* lds, int wave, int lane) {
    asm volatile("" : "+v"(lane));
    const bf16_t* qkv = (const bf16_t*)(a.ws + WS_QKV);
    bf16_t* OA = (bf16_t*)(a.ws + WS_OA); bf16_t* OB = OA;
    float* Oacc = (float*)(a.ws + WS_OACC); float* Lacc = (float*)(a.ws + WS_LACC);
    LAS unsigned char* wlds = lds + wave * WL_BYTES;
    constexpr int NHEAVY = (MC / 512) * 4, NLIGHT = (MC / 256) * 8;
#pragma unroll 1
    for (int it = blockIdx.x; it < NHEAVY + NLIGHT; it += gridDim.x) {
        if (it < NHEAVY) {
            const int hh = it & 3, span = it >> 2, grow = m0 + span * 512;
            int sstart, L;
            if (grow < MP) { sstart = grow & ~2047; L = 2048; } else { sstart = MP + ((grow - MP) & ~8191); L = 8192; }
#ifndef SKIP_HEAVY
            dilated_item(qkv, OA, Oacc, Lacc, a.rel_bias, sstart - m0, L, grow - sstart, hh, wlds, wave, lane);
#endif
        } else {
            const int j = it - NHEAVY, hb = j & 7, grow = m0 + (j >> 3) * 256;
            int sstart, L;
            if (grow < MP) { sstart = grow & ~2047; L = 2048; } else { sstart = MP + ((grow - MP) & ~8191); L = 8192; }
#ifndef SKIP_LIGHT
            nb_item(qkv, OB, a.rpb + (size_t)(l * 8 + hb) * (15 * 31), sstart - m0, L, grow - sstart, hb, wlds, wave, lane);
#endif
        }
    }
}

#define RLX_AGENT __ATOMIC_RELAXED, __HIP_MEMORY_SCOPE_AGENT
#define XB_TMO      128
#define XB_XCNT(j)  (256  + 64 * (j))
#define XB_XSUB(j)  (1280 + 64 * (j))
#define XB_XGEN(j)  (2304 + 64 * (j))
#define XB_TOP      3328
#define XB_TOPGEN   3392
#define XCD_BAR_WORDS 3456
#define XB_SPIN_CAP (1u << 18)

__device__ __forceinline__ unsigned xb_ld(unsigned* p)              { return __hip_atomic_load(p, __ATOMIC_RELAXED, __HIP_MEMORY_SCOPE_AGENT); }
__device__ __forceinline__ unsigned xb_add(unsigned* p, unsigned v) { return __hip_atomic_fetch_add(p, v, __ATOMIC_RELAXED, __HIP_MEMORY_SCOPE_AGENT); }
__device__ __forceinline__ unsigned xb_xcc_id() { return (unsigned)__builtin_amdgcn_s_getreg((3 << 11) | 20) & 0xFu; }
#define XB_SPIN(cond, bar) do { unsigned _sp = 0; while (cond) { __builtin_amdgcn_s_sleep(1); \
    if ((++_sp & 255u) == 0u) { if (xb_ld(&(bar)[XB_TMO])) break; if (_sp > XB_SPIN_CAP) { atomicAdd(&(bar)[XB_TMO], 1u); break; } } } } while (0)

struct XcdBarrier {
    unsigned* bar; unsigned x;
    volatile LAS unsigned* st;
};

__device__ __forceinline__ XcdBarrier xcd_barrier_post(unsigned* bar, volatile LAS unsigned* st) {
    XcdBarrier b; b.bar = bar; b.x = xb_xcc_id(); b.st = st;
    if (threadIdx.x == 0) (void)xb_add(&bar[XB_XCNT(b.x)], 1u);
    return b;
}
__device__ __forceinline__ void xcd_barrier_complete(unsigned* bar, unsigned x, unsigned& nloc, unsigned& nx) {
    const unsigned G = gridDim.x * gridDim.y * gridDim.z;
    unsigned sum, cnt, mine, sp = 0u;
    for (;;) {
        sum = 0u; cnt = 0u; mine = 0u;
#pragma unroll
        for (unsigned j = 0; j < 16; ++j) { const unsigned c = xb_ld(&bar[XB_XCNT(j)]); sum += c; cnt += (c > 0u) ? 1u : 0u; mine = (j == x) ? c : mine; }
        if (sum == G) break;
        __builtin_amdgcn_s_sleep(1);
        if ((++sp & 255u) == 0u) { if (xb_ld(&bar[XB_TMO])) break; if (sp > XB_SPIN_CAP) { atomicAdd(&bar[XB_TMO], 1u); break; } }
    }
    nloc = mine > 0u ? mine : 1u; nx = cnt > 0u ? cnt : 1u;
}

__device__ __forceinline__ void xcd_barrier(const XcdBarrier& b) {
    asm volatile("s_waitcnt vmcnt(0)" ::: "memory");
    __syncthreads();
    if (threadIdx.x == 0) {
        unsigned* bar = b.bar;
        __builtin_amdgcn_s_waitcnt(0);
        unsigned nloc = b.st[0], nx = b.st[1];
        if (nloc == 0u) { xcd_barrier_complete(bar, b.x, nloc, nx); b.st[0] = nloc; b.st[1] = nx; }
        const unsigned old = xb_add(&bar[XB_XSUB(b.x)], 1u);
        const unsigned gen = old / nloc;
        if (old + 1u == (gen + 1u) * nloc) {
            __builtin_amdgcn_fence(__ATOMIC_RELEASE, "agent");
            asm volatile("s_waitcnt vmcnt(0)" ::: "memory");
            const unsigned og = xb_add(&bar[XB_TOP], 1u);
            const unsigned tg = og / nx;
            if (og + 1u == (tg + 1u) * nx) xb_add(&bar[XB_TOPGEN], 1u);
            else XB_SPIN(xb_ld(&bar[XB_TOPGEN]) == tg, bar);
            __builtin_amdgcn_fence(__ATOMIC_ACQUIRE, "agent");
            xb_add(&bar[XB_XGEN(b.x)], 1u);
            asm volatile("s_waitcnt vmcnt(0)" ::: "memory");
        } else {
            XB_SPIN(xb_ld(&bar[XB_XGEN(b.x)]) == gen, bar);
            __builtin_amdgcn_fence(__ATOMIC_ACQUIRE, "agent");
            asm volatile("s_waitcnt vmcnt(0)" ::: "memory");
        }
    }
    __syncthreads();
}

#ifndef WO_MUL
#define WO_MUL 1.0f
#endif
#ifndef F2_MUL
#define F2_MUL 1.0f
#endif
#define GEMM_PHASE(EPI, Aptr, Bptr, Nn, Kk, Eobj) do { int K_ = (Kk); asm volatile("" : "+s"(K_)); pg8::Gemm g_{(const pg8::bf16_t*)(Aptr), (const pg8::bf16_t*)(Bptr), MC, (Nn), K_}; pg8::StaticOrder S_; S_.init(MC, (Nn), (int)gridDim.x, (int)blockIdx.x); \
        pg8::gemm_phase<EPI, pg8::StaticOrder, true, true>(lds, g_, S_, (Eobj)); } while (0)

#define GSYNC() xcd_barrier(bar)
__global__ void __launch_bounds__(NTHREADS, 2) mega_fwd(Args a_in) {
    extern __shared__ __attribute__((aligned(16))) unsigned char lds_raw[];
    LAS unsigned char* lds = (LAS unsigned char*)lds_raw;
    cg::grid_group grid = cg::this_grid();
    { volatile LAS unsigned* misc = (volatile LAS unsigned*)(lds + LDS_MISC); if (threadIdx.x < 16) misc[threadIdx.x] = 0u; }
    __syncthreads();
    grid.sync();
    const XcdBarrier bar = xcd_barrier_post((unsigned*)(a_in.ws + WS_CTL), (volatile LAS unsigned*)(lds + LDS_MISC + 32));
#pragma unroll 1
    for (int step = 0; step < 1 + NCHUNK * 16; ++step) {
        const Args& a = a_in;
        int tid = threadIdx.x; asm volatile("" : "+v"(tid));
        const int lane = tid & 63, wave = __builtin_amdgcn_readfirstlane(tid >> 6);
        const int gw = blockIdx.x * NWAVES + wave, NGW = gridDim.x * NWAVES;
        float* mod = (float*)(a.ws + WS_MOD);
        bf16_t* W = (bf16_t*)(a.ws + WS_W);
        bf16_t* H = (bf16_t*)(a.ws + WS_H);
        bf16_t* QKV = (bf16_t*)(a.ws + WS_QKV);
        bf16_t* G = (bf16_t*)(a.ws + WS_G);
        bf16_t* OA = (bf16_t*)(a.ws + WS_OA);
        bf16_t* OB = (bf16_t*)(a.ws + WS_OB);
        bf16_t* T = (bf16_t*)(a.ws + WS_QKV);
        bf16_t* U = (bf16_t*)(a.ws + WS_QKV);
        if (step == 0) {
            phase0(a, lds, tid, lane, wave, gw, NGW, 2);
        } else {
            const int s1 = step - 1, ch = s1 >> 4, l = (s1 >> 3) & 1, ph = s1 & 7;
            const int m0 = ch * MC;
            const float* xin0 = (ch == 0) ? a.x_prompt : a.x_sample + (size_t)(ch - 1) * MC * DM;
            float* xo = a.out + (size_t)m0 * DM;
            const float* xsrc = (l == 0) ? xin0 : (const float*)xo;
            const float* modl = mod + (size_t)l * 24 * NMOD;
            const bf16_t* Wl = W + (size_t)l * W_LAYER;
            if (ph == 0) {
                norm_phase(xsrc, H, a.norm1_g + l * DM, modl, 0, m0, gw, NGW, lane);
            } else if (ph == 1) {
                EpiQKVG E{QKV, G, a.q_norm_g + l * 1280, a.k_norm_g + l * 1280, a.b_gate + l * 2048, m0}; GEMM_PHASE(EpiQKVG, H, Wl + W_BT1, NG1, 1024, E);
            } else if (ph == 2) {
                attn_phase(a, l, m0, lds, wave, lane);
            } else if (ph == 3) {
                { EpiUp E{G, H}; GEMM_PHASE(EpiUp, OA, Wl + W_UA, 1024, 768, E); }
            } else if (ph == 4) {
                EpiRes E{xsrc, xo, modl + 2048, m0, 1.0f}; GEMM_PHASE(EpiRes, H, Wl + W_O, 1024, 1024, E);
            } else if (ph == 5) {
                norm_phase(xo, H, a.norm2_g + l * DM, modl, 3072, m0, gw, NGW, lane);
            } else if (ph == 6) {
                EpiF1 E{U, DFF}; GEMM_PHASE(EpiF1, H, Wl + W_F1, DFF, 1024, E);
            } else {
                EpiRes E{xo, xo, modl + 5120, m0, 1.0f}; GEMM_PHASE(EpiRes, U, Wl + W_F2, 1024, DFF, E);
            }
        }
        GSYNC();
    }
}

extern "C" void kernel_launch(void* const* d_in, const int* in_sizes, int n_in, void* d_out, int out_size, void* d_ws, size_t ws_size, hipStream_t stream) {
    static int grid = 0;
    if (grid == 0) {
        if (n_in != 20 || out_size != M_ALL * DM || ws_size < WS_END) { fprintf(stderr, "kernel_launch: unexpected shapes (n_in %d out %d ws %zu)\n", n_in, out_size, ws_size); grid = -1; return; }
        int dev = 0, cus = 0, per_cu = 0;
        (void)hipGetDevice(&dev);
        (void)hipDeviceGetAttribute(&cus, hipDeviceAttributeMultiprocessorCount, dev);
        if (hipFuncSetAttribute((const void*)mega_fwd, hipFuncAttributeMaxDynamicSharedMemorySize, LDS_BYTES) != hipSuccess) fprintf(stderr, "kernel_launch: hipFuncSetAttribute failed\n");
        if (hipOccupancyMaxActiveBlocksPerMultiprocessor(&per_cu, (const void*)mega_fwd, NTHREADS, LDS_BYTES) != hipSuccess || per_cu < 1) { fprintf(stderr, "kernel_launch: occupancy query says %d\n", per_cu); per_cu = 1; }
        (void)hipGetLastError();
        if (cus <= 0) cus = 256;
        grid = cus * per_cu;
    }
    if (grid < 0) return;
    if (hipMemsetAsync((char*)d_ws + WS_CTL, 0, CTL_BYTES, stream) != hipSuccess) { fprintf(stderr, "kernel_launch: memset failed\n"); return; }
    Args a{};
    const float** ap = (const float**)&a;
    for (int i = 0; i < 20; ++i) ap[i] = (const float*)d_in[i];
    a.out = (float*)d_out; a.ws = (unsigned char*)d_ws;
    void* args[] = {&a};
    hipError_t e = hipLaunchCooperativeKernel((const void*)mega_fwd, dim3(grid), dim3(NTHREADS), args, LDS_BYTES, stream);
    if (e != hipSuccess) fprintf(stderr, "kernel_launch: cooperative launch failed: %s (grid %d)\n", hipGetErrorString(e), grid);
}
```
